# Optimizing an MI355X kernel written in HIP

```python
import jax, jax.numpy as jnp
from jax import lax
import numpy as np

D_MODEL = 2048
BATCH = 1
SEQ = 16384
DEPTH = 2

N_MIXERS = 2
N_META = 16
BLOCK = 128
META_PAD = (-N_META) % BLOCK
RMS_EPS = 1e-6
NEG = -1e30
HG_EXPAND = 128
HG_HEADS = D_MODEL // HG_EXPAND
HG_DK = HG_EXPAND
HG_DV = D_MODEL // HG_HEADS
HG_FDIM = HG_HEADS * HG_DK
HG_IN = 2 * HG_FDIM + 2 * D_MODEL
FOX_HEAD_DIM = 128
FOX_HEADS = D_MODEL // FOX_HEAD_DIM
FOX_IN = 4 * D_MODEL + FOX_HEADS
FFN_DIM = 5504
N_HGRN = (DEPTH + 1) // 2
N_FOX = DEPTH // 2

kernel_name = "hybrid_hgrn2_fox_macaron_meta"


def rmsnorm(x, gain):
    xf = x.astype(jnp.float32)
    y = xf * lax.rsqrt(jnp.mean(xf * xf, axis=-1, keepdims=True) + RMS_EPS)
    return (y * gain.astype(jnp.float32)).astype(x.dtype)


def swiglu(x, w_gu, w_down):
    a, b = jnp.split(x @ w_gu, 2, axis=-1)
    return (jax.nn.silu(a) * b) @ w_down


def pad_front(t):
    widths = [(0, 0)] * t.ndim
    widths[1] = (META_PAD, 0)
    return jnp.pad(t, widths)


def hgrn2_chunk(S, inp):
    q, k, v, g = inp
    C = q.shape[2]
    causal = jnp.tril(jnp.ones((C, C), dtype=bool))
    b = jnp.cumsum(g, axis=2)
    diff = b[:, :, :, None, :] - b[:, :, None, :, :]
    decay = jnp.exp(jnp.where(causal[:, :, None], diff, -jnp.inf))
    attn = jnp.einsum('bhtd,bhsd,bhtsd->bhts', q, k, decay)
    o = jnp.einsum('bhts,bhsv->bhtv', attn, v) + jnp.einsum('bhtd,bhdv->bhtv', q * jnp.exp(b), S)
    b_last = b[:, :, -1:, :]
    S = jnp.exp(b_last[:, :, 0, :])[..., None] * S + jnp.einsum('bhsd,bhsv->bhdv', k * jnp.exp(b_last - b), v)
    return S, o


def hgrn2_mixer(xn, w_in, w_out, lb, onorm):
    B, L, _ = xn.shape
    q, f, i, g = jnp.split(xn @ w_in, [HG_FDIM, 2 * HG_FDIM, 2 * HG_FDIM + D_MODEL], axis=-1)
    q = jax.nn.silu(q.astype(jnp.float32))
    fg = lb + (1.0 - lb) * jax.nn.sigmoid(f.astype(jnp.float32))
    k = 1.0 - fg
    logf = jnp.log(fg)
    v = i.astype(jnp.float32)

    def to_chunks(t, hd):
        t = pad_front(t)
        n = t.shape[1] // BLOCK
        return t.reshape(B, n, BLOCK, HG_HEADS, hd).transpose(1, 0, 3, 2, 4)

    S0 = jnp.zeros((B, HG_HEADS, HG_DK, HG_DV), jnp.float32)
    _, o = lax.scan(hgrn2_chunk, S0, (to_chunks(q, HG_DK), to_chunks(k, HG_DK),
                                       to_chunks(v, HG_DV), to_chunks(logf, HG_DK)))
    Lp = L + META_PAD
    o = o.transpose(1, 0, 3, 2, 4).reshape(B, Lp, HG_HEADS, HG_DV)[:, META_PAD:]
    o = rmsnorm(o, onorm).reshape(B, L, D_MODEL)
    o = o * jax.nn.sigmoid(g.astype(jnp.float32))
    return o.astype(xn.dtype) @ w_out


def fox_mixer(xn, w_in, b_f, w_out, qnorm, knorm):
    B, L, _ = xn.shape
    H, dh = FOX_HEADS, FOX_HEAD_DIM
    q, k, v, g, f = jnp.split(xn @ w_in, [D_MODEL, 2 * D_MODEL, 3 * D_MODEL, 4 * D_MODEL], axis=-1)
    q = rmsnorm(q.reshape(B, L, H, dh), qnorm)
    k = rmsnorm(k.reshape(B, L, H, dh), knorm)
    v = v.reshape(B, L, H, dh)
    logf = jax.nn.log_sigmoid((f + b_f).astype(jnp.float32))
    q, k, v, logf = pad_front(q), pad_front(k), pad_front(v), pad_front(logf)
    Lp = L + META_PAD
    nB = Lp // BLOCK
    c = jnp.cumsum(logf, axis=1).transpose(0, 2, 1)
    qh = q.transpose(0, 2, 1, 3)
    kh = k.transpose(0, 2, 1, 3)
    vh = v.transpose(0, 2, 1, 3)
    q_blocks = qh.reshape(B, H, nB, BLOCK, dh).transpose(2, 0, 1, 3, 4)
    c_blocks = c.reshape(B, H, nB, BLOCK).transpose(2, 0, 1, 3)
    starts = jnp.arange(nB, dtype=jnp.int32) * BLOCK
    key_pos = jnp.arange(Lp, dtype=jnp.int32)
    key_real = key_pos >= META_PAD
    scale = dh ** -0.5

    def attend(args):
        qb, cb, start = args
        s = jnp.einsum('bhqd,bhkd->bhqk', qb, kh).astype(jnp.float32) * scale
        s = s + cb[..., :, None] - c[..., None, :]
        qpos = start + jnp.arange(BLOCK, dtype=jnp.int32)
        mask = (key_pos[None, :] <= qpos[:, None]) & key_real[None, :]
        p = jax.nn.softmax(jnp.where(mask, s, NEG), axis=-1)
        return jnp.einsum('bhqk,bhkd->bhqd', p.astype(vh.dtype), vh)

    o = lax.map(attend, (q_blocks, c_blocks, starts))
    o = o.transpose(1, 0, 3, 2, 4).reshape(B, Lp, D_MODEL)[:, META_PAD:]
    o = o * jax.nn.sigmoid(g.astype(jnp.float32)).astype(o.dtype)
    return o @ w_out


def setup_inputs(seed: int = 0) -> dict:
    key = jax.random.key(seed)
    ks = jax.random.split(key, 16)
    nrm = jax.random.normal
    D = D_MODEL
    return {
        "x": nrm(ks[0], (BATCH, SEQ, D), jnp.float32),
        "meta_tokens": nrm(ks[1], (N_META, D), jnp.float32),
        "norm_g": 1.0 + 0.02 * nrm(ks[2], (DEPTH, 3, D), jnp.float32),
        "ffn_w_gu": nrm(ks[3], (DEPTH, 2, D, 2 * FFN_DIM), jnp.float32) * D ** -0.5,
        "ffn_w_down": nrm(ks[4], (DEPTH, 2, FFN_DIM, D), jnp.float32) * FFN_DIM ** -0.5,
        "lb_logits": 0.5 * nrm(ks[5], (DEPTH + 1, HG_FDIM), jnp.float32),
        "hg_w_in": nrm(ks[6], (N_HGRN, D, HG_IN), jnp.float32) * D ** -0.5,
        "hg_w_out": nrm(ks[7], (N_HGRN, D, D), jnp.float32) * D ** -0.5,
        "hg_onorm": 1.0 + 0.02 * nrm(ks[8], (N_HGRN, HG_DV), jnp.float32),
        "fox_w_in": nrm(ks[9], (N_FOX, D, FOX_IN), jnp.float32) * D ** -0.5,
        "fox_b_f": 2.0 + 0.1 * nrm(ks[10], (N_FOX, FOX_HEADS), jnp.float32),
        "fox_w_out": nrm(ks[11], (N_FOX, D, D), jnp.float32) * D ** -0.5,
        "fox_qnorm": 1.0 + 0.02 * nrm(ks[12], (N_FOX, FOX_HEAD_DIM), jnp.float32),
        "fox_knorm": 1.0 + 0.02 * nrm(ks[13], (N_FOX, FOX_HEAD_DIM), jnp.float32),
    }


def reference(x, meta_tokens, norm_g, ffn_w_gu, ffn_w_down, lb_logits, hg_w_in, hg_w_out,
              hg_onorm, fox_w_in, fox_b_f, fox_w_out, fox_qnorm, fox_knorm):
    B = x.shape[0]
    lbs = jnp.cumsum(jax.nn.softmax(lb_logits.astype(jnp.float32), axis=0), axis=0)
    meta = jnp.broadcast_to(meta_tokens.astype(x.dtype)[None], (B, N_META, D_MODEL))
    h = jnp.concatenate([meta, x], axis=1)
    for layer in range(DEPTH):
        h = h + 0.5 * swiglu(rmsnorm(h, norm_g[layer, 0]), ffn_w_gu[layer, 0], ffn_w_down[layer, 0])
        hn = rmsnorm(h, norm_g[layer, 1])
        j = layer // N_MIXERS
        if layer % N_MIXERS == 0:
            mix = hgrn2_mixer(hn, hg_w_in[j], hg_w_out[j], lbs[layer], hg_onorm[j])
        else:
            mix = fox_mixer(hn, fox_w_in[j], fox_b_f[j], fox_w_out[j], fox_qnorm[j], fox_knorm[j])
        h = h + mix
        h = h + 0.5 * swiglu(rmsnorm(h, norm_g[layer, 2]), ffn_w_gu[layer, 1], ffn_w_down[layer, 1])
    return h[:, N_META:]
```

```cpp
#include <hip/hip_runtime.h>
#include <hip/hip_cooperative_groups.h>
#include <cstdio>
#include <cstdint>
namespace cg = cooperative_groups;

#define LAS __attribute__((address_space(3)))
typedef unsigned short bf16_t;
typedef short bf16x8 __attribute__((ext_vector_type(8)));
typedef short s16x4 __attribute__((ext_vector_type(4)));
typedef float f32x4 __attribute__((ext_vector_type(4)));
typedef float f32x2 __attribute__((ext_vector_type(2)));
typedef float f32x16 __attribute__((ext_vector_type(16)));
typedef unsigned u32x4 __attribute__((ext_vector_type(4)));
typedef unsigned u32x2 __attribute__((ext_vector_type(2)));

constexpr int DM = 2048, SEQ = 16384, NMETA = 16, FF = 5504, NH = 16, HD = 128;
constexpr int TR = 16640;
constexpr int ROW_META = 240, ROW_X = 256;
constexpr int NCHUNK = TR / 128;
constexpr int HG_N = 8192, FX_N = 8448  , FX_NREAL = 8208;
constexpr float RMS_EPS = 1e-6f;
constexpr int NTHREADS = 512, NWAVES = 8;

constexpr size_t al256(size_t x) { return (x + 255) & ~(size_t)255; }
constexpr size_t WS_CTL = 0;
constexpr size_t WS_WGU = 16384;
constexpr size_t SZ_WGU1 = (size_t)2 * FF * DM * 2;
constexpr size_t WS_WDN = WS_WGU + 4 * SZ_WGU1;
constexpr size_t SZ_WDN1 = (size_t)DM * FF * 2;
constexpr size_t WS_WHI = WS_WDN + 4 * SZ_WDN1;
constexpr size_t WS_WHO = WS_WHI + (size_t)HG_N * DM * 2;
constexpr size_t WS_WFI = WS_WHO + (size_t)DM * DM * 2;
constexpr size_t WS_WFO = WS_WFI + (size_t)FX_N * DM * 2;
constexpr size_t WS_H = WS_WFO + (size_t)DM * DM * 2;
constexpr size_t WS_HB = WS_H + (size_t)TR * DM * 4;
constexpr size_t WS_SSQ = WS_HB + (size_t)TR * DM * 2;
constexpr size_t WS_LB = WS_SSQ + al256((size_t)6 * TR * 4);
constexpr size_t WS_U0 = WS_LB + 8192;
constexpr size_t WS_ACT = WS_U0;
constexpr size_t SZ_TB = (size_t)TR * DM * 2;
constexpr size_t WS_QB = WS_U0, WS_KB = WS_QB + SZ_TB, WS_VB = WS_KB + SZ_TB, WS_GB = WS_VB + SZ_TB, WS_OG = WS_GB + SZ_TB;
constexpr size_t WS_LF = WS_OG + SZ_TB;
constexpr size_t WS_UT = WS_LF + (size_t)TR * DM * 4;
constexpr size_t WS_ST = WS_UT + (size_t)NCHUNK * NH * HD * HD * 4;
constexpr size_t WS_DEC = WS_ST + (size_t)NCHUNK * NH * HD * HD * 2;
constexpr size_t WS_LFX = WS_DEC + al256((size_t)NCHUNK * NH * HD * 4);
constexpr size_t WS_LOC = WS_LFX + (size_t)TR * 16 * 4;
constexpr size_t WS_SEG = WS_LOC + (size_t)TR * 16 * 4;
constexpr size_t WS_RK = WS_SEG + al256((size_t)NCHUNK * 16 * 4);
constexpr size_t WS_END = WS_RK + (size_t)TR * 16 * 4;
static_assert(WS_ACT + (size_t)TR * FF * 2 <= WS_END, "act fits in union");
static_assert(WS_END <= (size_t)4 * 2 * 2 * DM * 2 * FF * 4, "workspace exceeds the guaranteed 4x largest tensor");

constexpr int LDS_BYTES = 147456 + 1024;
constexpr int LDS_XST = 147456;

typedef __bf16 bf16x2_t __attribute__((ext_vector_type(2)));
__device__ __forceinline__ unsigned cvtpk(float lo, float hi) { bf16x2_t v = {(__bf16)lo, (__bf16)hi}; return __builtin_bit_cast(unsigned, v); }
__device__ __forceinline__ float bf2f(unsigned short b) { return __uint_as_float(((unsigned)b) << 16); }
__device__ __forceinline__ float bflo(unsigned w) { return __uint_as_float(w << 16); }
__device__ __forceinline__ float bfhi(unsigned w) { return __uint_as_float(w & 0xffff0000u); }
__device__ __forceinline__ bf16x8 pack8(f32x4 a, f32x4 b) { u32x4 w = {cvtpk(a[0], a[1]), cvtpk(a[2], a[3]), cvtpk(b[0], b[1]), cvtpk(b[2], b[3])}; return *reinterpret_cast<bf16x8*>(&w); }
__device__ __forceinline__ float fexp(float x) { return __builtin_amdgcn_exp2f(x * 1.4426950408889634f); }
__device__ __forceinline__ float sigmoidf_(float x) { return __builtin_amdgcn_rcpf(1.0f + fexp(-x)); }
__device__ __forceinline__ float wave_sum(float v) {
#pragma unroll
    for (int o = 1; o < 64; o <<= 1) v += __shfl_xor(v, o);
    return v;
}

namespace pg8 {
constexpr int BM = 256, BK = 64, HALF = 128, HTB = HALF * BK * 2, STAGE_BYTES = 8 * HTB, NXCD = 8, WGM = 8;
__host__ __device__ __forceinline__ int lds_byte(int r, int c) { const int st = (r >> 4) * 2 + (c >> 5), rr = r & 15, cc = c & 31, ob = rr * 64 + cc * 2; return st * 1024 + (ob ^ (((ob >> 9) & 1) << 5)); }
__host__ __device__ __forceinline__ void stage_rc(int b, int& R, int& C) { const int st = b / 1024, sb = b % 1024, swz = sb ^ (((sb >> 9) & 1) << 5); R = (st >> 1) * 16 + swz / 64; C = (st & 1) * 32 + (swz % 64) / 2; }
__host__ __device__ __forceinline__ int perm32(int rho) { const int n = rho >> 4, i = rho & 15; return 8 * (i >> 2) + 4 * n + (i & 3); }
struct Unit { int pm, pn; };
struct Gemm { const bf16_t* A; const bf16_t* Bt; int M, N, K; };
struct StaticOrder {
    int nM, nN, nwg, G, c;
    __device__ void init(int M, int N, int G_, int c_) { nM = M / BM; nN = N / BM; nwg = nM * nN; G = G_; c = c_; }
    __device__ bool next(int i, Unit& u) const {
        const long L = (long)i * G + c; if (L >= nwg) return false;
        int wgid = (int)L; { const int q = nwg / NXCD, r = nwg % NXCD, xcd = wgid % NXCD, off = wgid / NXCD; wgid = (xcd < r ? xcd * (q + 1) : r * (q + 1) + (xcd - r) * q) + off; }
        const int nig = WGM * nN, gid = wgid / nig, fm = gid * WGM, gsz = (nM - fm) < WGM ? (nM - fm) : WGM;
        u.pm = fm + ((wgid % nig) % gsz); u.pn = (wgid % nig) / gsz; return true;
    }
};

template <class Epi>
__device__ __forceinline__ void gemm_phase(LAS unsigned char* lds, const Gemm g, const StaticOrder& S, const Epi& E) {
    const int tid = threadIdx.x, wid = __builtin_amdgcn_readfirstlane(tid >> 6), lane = tid & 63, wr = wid >> 2, wc = wid & 3, fr = lane & 15, fq = lane >> 4;
    const int K = g.K, nt = K / BK;
    unsigned voffA[2], voffB[2];
#pragma unroll
    for (int i = 0; i < 2; ++i) { int R, C; stage_rc(tid * 16 + i * 8192, R, C); const int Rb = Epi::PERM ? ((R & ~31) + perm32(R & 31)) : R;
        voffA[i] = (unsigned)(R * K + C) * 2u; voffB[i] = (unsigned)(Rb * K + C) * 2u; }
    const size_t kstep = (size_t)(BK * 2);
    const size_t hstep = (size_t)HALF * K * 2;
    const size_t tstep = 2 * hstep;
    const unsigned ldsw = (unsigned)wid * 1024u;
    const int aoff = lds_byte(wr * 64 + fr, fq * 8), boff = lds_byte(wc * 32 + fr, fq * 8);
#define PG8_SA(b, h) (((b) * 2 + (h)) * HTB)
#define PG8_SB(b, h) ((4 + (b) * 2 + (h)) * HTB)
#define PG8_STAGE(bufoff, gbase, voff) do { _Pragma("unroll") for (int _i = 0; _i < 2; ++_i) \
        __builtin_amdgcn_global_load_lds((const unsigned*)((const char*)(gbase) + (voff)[_i]), (LAS unsigned*)(lds + (bufoff) + ldsw + _i * 8192), 16, 0, 0); } while (0)
#define PG8_LDA(dst, b, h) do { _Pragma("unroll") for (int m = 0; m < 4; ++m) _Pragma("unroll") for (int k = 0; k < 2; ++k) dst[m][k] = *(const LAS bf16x8*)(lds + PG8_SA(b, h) + aoff + m * 2048 + k * 1024); } while (0)
#define PG8_LDB(dst, b, h) do { _Pragma("unroll") for (int n = 0; n < 2; ++n) _Pragma("unroll") for (int k = 0; k < 2; ++k) dst[n][k] = *(const LAS bf16x8*)(lds + PG8_SB(b, h) + boff + n * 2048 + k * 1024); } while (0)
#define PG8_MMA(ai, bj, At, Bt) do { __builtin_amdgcn_s_setprio(1); _Pragma("unroll") for (int m = 0; m < 4; ++m) _Pragma("unroll") for (int n = 0; n < 2; ++n) _Pragma("unroll") for (int k = 0; k < 2; ++k) \
        acc[ai][bj][m][n] = __builtin_amdgcn_mfma_f32_16x16x32_bf16(Bt[n][k], At[m][k], acc[ai][bj][m][n], 0, 0, 0); __builtin_amdgcn_s_setprio(0); } while (0)
#define PG8_WAIT_V(n) asm volatile("s_waitcnt vmcnt(" #n ")" ::: "memory")
#define PG8_WAIT_L(n) asm volatile("s_waitcnt lgkmcnt(" #n ")" ::: "memory")
#define PG8_BAR __builtin_amdgcn_s_barrier()
#define PG8_SCHED __builtin_amdgcn_sched_barrier(0)
    Unit cur, nxt; int ui = 0;
    if (!S.next(0, cur)) return;
    f32x4 acc[2][2][4][2];
#pragma unroll
    for (int a = 0; a < 2; ++a)
#pragma unroll
        for (int b = 0; b < 2; ++b)
#pragma unroll
            for (int m = 0; m < 4; ++m)
#pragma unroll
                for (int n = 0; n < 2; ++n) acc[a][b][m][n] = (f32x4){0.f, 0.f, 0.f, 0.f};
    bf16x8 At[4][2], B0[2][2], B1[2][2];
    const char* cA = (const char*)g.A + (size_t)cur.pm * tstep; const char* cB = (const char*)g.Bt + (size_t)cur.pn * tstep;
    typename Epi::Pre pre = E.pre(cur, wr, fr);
    PG8_STAGE(PG8_SB(0, 0), cB, voffB); PG8_STAGE(PG8_SA(0, 0), cA, voffA); PG8_STAGE(PG8_SB(0, 1), cB + hstep, voffB); PG8_STAGE(PG8_SA(0, 1), cA + hstep, voffA);
    if (wr == 1) PG8_BAR;
    PG8_WAIT_V(4); PG8_BAR;
    PG8_STAGE(PG8_SB(1, 0), cB + kstep, voffB); PG8_STAGE(PG8_SA(1, 0), cA + kstep, voffA); PG8_STAGE(PG8_SB(1, 1), cB + hstep + kstep, voffB);
    PG8_WAIT_V(6); PG8_BAR;
    for (;;) {
        const bool has_next = S.next(ui + 1, nxt);
        const char* nA = has_next ? (const char*)g.A + (size_t)nxt.pm * tstep : cA; const char* nB = has_next ? (const char*)g.Bt + (size_t)nxt.pn * tstep : cB;
        for (int t = 0; t < nt; t += 2) {
            const bool last = (t == nt - 2);
            const char* a1 = cA + (size_t)(t + 1) * kstep;
            const char* a2 = last ? nA : cA + (size_t)(t + 2) * kstep; const char* b2 = last ? nB : cB + (size_t)(t + 2) * kstep;
            const char* a3 = a2 + kstep; const char* b3 = b2 + kstep;
            PG8_LDB(B0, 0, 0); PG8_SCHED; PG8_LDA(At, 0, 0); PG8_STAGE(PG8_SA(1, 1), a1 + hstep, voffA);
            PG8_WAIT_L(8); PG8_BAR; PG8_WAIT_L(0); PG8_MMA(0, 0, At, B0); PG8_BAR; PG8_SCHED;
            PG8_LDB(B1, 0, 1); PG8_STAGE(PG8_SB(0, 0), b2, voffB);
            PG8_BAR; PG8_WAIT_L(0); PG8_MMA(0, 1, At, B1); PG8_BAR;
            PG8_LDA(At, 0, 1); PG8_STAGE(PG8_SA(0, 0), a2, voffA);
            PG8_BAR; PG8_WAIT_L(0); PG8_MMA(1, 0, At, B0); PG8_BAR; PG8_SCHED;
            PG8_STAGE(PG8_SB(0, 1), b2 + hstep, voffB);
            PG8_WAIT_V(6); PG8_BAR; PG8_MMA(1, 1, At, B1); PG8_BAR;
            PG8_LDB(B0, 1, 0); PG8_SCHED; PG8_LDA(At, 1, 0); PG8_STAGE(PG8_SA(0, 1), a2 + hstep, voffA);
            PG8_WAIT_L(8); PG8_BAR; PG8_WAIT_L(0); PG8_MMA(0, 0, At, B0); PG8_BAR; PG8_SCHED;
            PG8_LDB(B1, 1, 1); PG8_STAGE(PG8_SB(1, 0), b3, voffB);
            PG8_BAR; PG8_WAIT_L(0); PG8_MMA(0, 1, At, B1); PG8_BAR;
            PG8_LDA(At, 1, 1); PG8_STAGE(PG8_SA(1, 0), a3, voffA);
            PG8_BAR; PG8_WAIT_L(0); PG8_MMA(1, 0, At, B0); PG8_BAR; PG8_SCHED;
            PG8_STAGE(PG8_SB(1, 1), b3 + hstep, voffB);
            PG8_WAIT_V(6); PG8_BAR; PG8_MMA(1, 1, At, B1); PG8_BAR;
        }
        E(acc, cur, wr, wc, fr, fq, pre);
        if (!has_next) break;
        pre = E.pre(nxt, wr, fr);
#pragma unroll
        for (int a = 0; a < 2; ++a)
#pragma unroll
            for (int b = 0; b < 2; ++b)
#pragma unroll
                for (int m = 0; m < 4; ++m)
#pragma unroll
                    for (int n = 0; n < 2; ++n) acc[a][b][m][n] = (f32x4){0.f, 0.f, 0.f, 0.f};
        cur = nxt; cA = nA; cB = nB; ++ui;
    }
    PG8_WAIT_V(0);
    if (wr == 0) PG8_BAR;
    PG8_BAR;
#undef PG8_SA
#undef PG8_SB
#undef PG8_STAGE
#undef PG8_LDA
#undef PG8_LDB
#undef PG8_MMA
#undef PG8_WAIT_V
#undef PG8_WAIT_L
#undef PG8_BAR
#undef PG8_SCHED
}
}
using pg8::Unit; using pg8::HALF; using pg8::BM;

__device__ __forceinline__ float row_rs(const float* ssq, int r) { return __builtin_amdgcn_rsqf(ssq[r] * (1.0f / DM) + RMS_EPS); }

struct PreRs { float rs[8]; };
__device__ __forceinline__ PreRs load_rs(const float* ssq, int pm, int wr, int fr) { PreRs p;
#pragma unroll
    for (int ai = 0; ai < 2; ++ai)
#pragma unroll
        for (int m = 0; m < 4; ++m) p.rs[ai * 4 + m] = ssq[ROW_X + pm * BM + ai * HALF + wr * 64 + m * 16 + fr];
    return p; }
struct PreNone {};
struct EpiSwiGLU {
    static constexpr bool PERM = true;
    bf16_t* O; const float* ssq; typedef PreRs Pre;
    __device__ __forceinline__ Pre pre(const Unit& u, int wr, int fr) const { return load_rs(ssq, u.pm, wr, fr); }
    __device__ __forceinline__ void operator()(const f32x4 (&acc)[2][2][4][2], const Unit& u, int wr, int wc, int fr, int fq, const Pre& P) const {
        const int row0 = ROW_X + u.pm * BM + wr * 64 + fr, col0 = u.pn * HALF + wc * 32 + 8 * fq;
#pragma unroll
        for (int ai = 0; ai < 2; ++ai)
#pragma unroll
            for (int m = 0; m < 4; ++m) { const int r = row0 + ai * HALF + m * 16; const float rs = __builtin_amdgcn_rsqf(P.rs[ai * 4 + m] * (1.0f / DM) + RMS_EPS);
                float y[8];
#pragma unroll
                for (int n = 0; n < 2; ++n)
#pragma unroll
                    for (int j = 0; j < 4; ++j) { const float a = acc[ai][0][m][n][j] * rs, b = acc[ai][1][m][n][j] * rs; y[n * 4 + j] = a * b * sigmoidf_(a); }
                u32x4 w; w.x = cvtpk(y[0], y[1]); w.y = cvtpk(y[2], y[3]); w.z = cvtpk(y[4], y[5]); w.w = cvtpk(y[6], y[7]);
                *(u32x4*)(O + (size_t)r * FF + col0) = w; }
    }
};
template <bool FINAL> struct EpiResid {
    static constexpr bool PERM = true;
    bf16_t* HB; float* ssq_out; float* OUT; float alpha; typedef PreNone Pre;
    __device__ __forceinline__ Pre pre(const Unit&, int, int) const { return Pre{}; }
    __device__ __forceinline__ void operator()(const f32x4 (&acc)[2][2][4][2], const Unit& u, int wr, int wc, int fr, int fq, const Pre&) const {
        const int row0 = ROW_X + u.pm * BM + wr * 64 + fr, col0 = u.pn * BM + wc * 32 + 8 * fq;
        u32x4 hv[2][2]; float sprev = 0.f;
#define ER_LOAD(g_, set_) do { const size_t off_ = (size_t)(row0 + ((g_) >> 2) * HALF + ((g_) & 3) * 16) * DM + col0; \
        hv[set_][0] = *(const u32x4*)(HB + off_); hv[set_][1] = *(const u32x4*)(HB + off_ + HALF); } while (0)
        ER_LOAD(0, 0);
#pragma unroll
        for (int g = 0; g < 8; ++g) { const int ai = g >> 2, m = g & 3; const int r = row0 + ai * HALF + m * 16; const size_t off = (size_t)r * DM + col0; float s = 0.f;
            if (g + 1 < 8) ER_LOAD(g + 1, (g + 1) & 1);
#pragma unroll
            for (int bj = 0; bj < 2; ++bj) { const u32x4 w = hv[g & 1][bj];
                const f32x4 h0 = {bflo(w.x), bfhi(w.x), bflo(w.y), bfhi(w.y)}, h1 = {bflo(w.z), bfhi(w.z), bflo(w.w), bfhi(w.w)};
                const f32x4 o0 = h0 + acc[ai][bj][m][0] * alpha, o1 = h1 + acc[ai][bj][m][1] * alpha;
                if (FINAL) { float* op = OUT + (size_t)(r - ROW_X) * DM + col0 + bj * HALF; *(f32x4*)op = o0; *(f32x4*)(op + 4) = o1; }
                else { u32x4 q; q.x = cvtpk(o0[0], o0[1]); q.y = cvtpk(o0[2], o0[3]); q.z = cvtpk(o1[0], o1[1]); q.w = cvtpk(o1[2], o1[3]); *(u32x4*)(HB + off + bj * HALF) = q;
                       s += ((o0[0] * o0[0] + o0[1] * o0[1]) + (o0[2] * o0[2] + o0[3] * o0[3])) + ((o1[0] * o1[0] + o1[1] * o1[1]) + (o1[2] * o1[2] + o1[3] * o1[3])); } }
            if (!FINAL) { if (g > 0) { float t = sprev; t += __shfl_xor(t, 16); t += __shfl_xor(t, 32);
                    if (fq == 0) __hip_atomic_fetch_add(ssq_out + row0 + ((g - 1) >> 2) * HALF + ((g - 1) & 3) * 16, t, __ATOMIC_RELAXED, __HIP_MEMORY_SCOPE_AGENT); }
                sprev = s; } }
#undef ER_LOAD
        if (!FINAL) { float t = sprev; t += __shfl_xor(t, 16); t += __shfl_xor(t, 32);
            if (fq == 0) __hip_atomic_fetch_add(ssq_out + row0 + HALF + 48, t, __ATOMIC_RELAXED, __HIP_MEMORY_SCOPE_AGENT); }
    }
};
struct EpiHgIn {
    static constexpr bool PERM = true;
    bf16_t* QB; bf16_t* KB; bf16_t* VB; bf16_t* GB; float* LF; const float* LBv; const float* ssq; typedef PreRs Pre;
    __device__ __forceinline__ Pre pre(const Unit& u, int wr, int fr) const { return load_rs(ssq, u.pm, wr, fr); }
    __device__ __forceinline__ void operator()(const f32x4 (&acc)[2][2][4][2], const Unit& u, int wr, int wc, int fr, int fq, const Pre& P) const {
        const int sec = u.pn >> 3, row0 = ROW_X + u.pm * BM + wr * 64 + fr, colb = (u.pn & 7) * BM + wc * 32 + 8 * fq;
#pragma unroll
        for (int ai = 0; ai < 2; ++ai)
#pragma unroll
            for (int m = 0; m < 4; ++m) { const int r = row0 + ai * HALF + m * 16; const float rs = __builtin_amdgcn_rsqf(P.rs[ai * 4 + m] * (1.0f / DM) + RMS_EPS);
#pragma unroll
                for (int bj = 0; bj < 2; ++bj) { const int c = colb + bj * HALF; const size_t off = (size_t)r * DM + c; float x[8], y[8];
#pragma unroll
                    for (int n = 0; n < 2; ++n)
#pragma unroll
                        for (int j = 0; j < 4; ++j) x[n * 4 + j] = acc[ai][bj][m][n][j] * rs;
                    bf16_t* dst;
                    if (sec == 0) { dst = QB;
#pragma unroll
                        for (int j = 0; j < 8; ++j) y[j] = x[j] * sigmoidf_(x[j]); }
                    else if (sec == 1) { dst = KB; const f32x4 l0 = *(const f32x4*)(LBv + c), l1 = *(const f32x4*)(LBv + c + 4); float lf[8];
#pragma unroll
                        for (int j = 0; j < 8; ++j) { const float lb = j < 4 ? l0[j] : l1[j - 4]; const float fg = lb + (1.0f - lb) * sigmoidf_(x[j]); y[j] = 1.0f - fg; lf[j] = __logf(fg); }
                        *(f32x4*)(LF + off) = (f32x4){lf[0], lf[1], lf[2], lf[3]}; *(f32x4*)(LF + off + 4) = (f32x4){lf[4], lf[5], lf[6], lf[7]}; }
                    else if (sec == 2) { dst = VB;
#pragma unroll
                        for (int j = 0; j < 8; ++j) y[j] = x[j]; }
                    else { dst = GB;
#pragma unroll
                        for (int j = 0; j < 8; ++j) y[j] = sigmoidf_(x[j]); }
                    u32x4 w; w.x = cvtpk(y[0], y[1]); w.y = cvtpk(y[2], y[3]); w.z = cvtpk(y[4], y[5]); w.w = cvtpk(y[6], y[7]);
                    *(u32x4*)(dst + off) = w; } }
    }
};
struct EpiFoxIn {
    static constexpr bool PERM = true;
    bf16_t* QB; bf16_t* KB; bf16_t* VB; bf16_t* GB; float* LFX; const float* bfv; const float* ssq; typedef PreRs Pre;
    __device__ __forceinline__ Pre pre(const Unit& u, int wr, int fr) const { return load_rs(ssq, u.pm, wr, fr); }
    __device__ __forceinline__ void operator()(const f32x4 (&acc)[2][2][4][2], const Unit& u, int wr, int wc, int fr, int fq, const Pre& P) const {
        const int sec = u.pn >> 3, row0 = ROW_X + u.pm * BM + wr * 64 + fr, colb = (u.pn & 7) * BM + wc * 32 + 8 * fq;
#pragma unroll
        for (int ai = 0; ai < 2; ++ai)
#pragma unroll
            for (int m = 0; m < 4; ++m) { const int r = row0 + ai * HALF + m * 16; const float rs = __builtin_amdgcn_rsqf(P.rs[ai * 4 + m] * (1.0f / DM) + RMS_EPS);
                if (sec == 4) {
                    if (wc == 0 && fq < 2) {
#pragma unroll
                        for (int n = 0; n < 2; ++n) { f32x4 o;
#pragma unroll
                            for (int j = 0; j < 4; ++j) { const float z = acc[ai][0][m][n][j] * rs + bfv[8 * fq + 4 * n + j]; o[j] = fminf(z, 0.f) - __logf(1.0f + fexp(-fabsf(z))); }
                            *(f32x4*)(LFX + (size_t)r * 16 + 8 * fq + 4 * n) = o; } }
                } else {
#pragma unroll
                    for (int bj = 0; bj < 2; ++bj) { const size_t off = (size_t)r * DM + colb + bj * HALF; float y[8];
#pragma unroll
                        for (int n = 0; n < 2; ++n)
#pragma unroll
                            for (int j = 0; j < 4; ++j) { const float x = acc[ai][bj][m][n][j] * rs; y[n * 4 + j] = (sec == 3) ? sigmoidf_(x) : x; }
                        bf16_t* dst = sec == 0 ? QB : sec == 1 ? KB : sec == 2 ? VB : GB;
                        u32x4 w; w.x = cvtpk(y[0], y[1]); w.y = cvtpk(y[2], y[3]); w.z = cvtpk(y[4], y[5]); w.w = cvtpk(y[6], y[7]);
                        *(u32x4*)(dst + off) = w; } } }
    }
};

struct Args {
    const float* x; const float* meta; const float* norm_g; const float* w_gu; const float* w_dn; const float* lb_logits; const float* hg_w_in; const float* hg_w_out;
    const float* hg_onorm; const float* fox_w_in; const float* fox_b_f; const float* fox_w_out; const float* fox_qnorm; const float* fox_knorm;
    float* out; unsigned char* ws; int ph_lo, ph_hi;
};
#ifndef PHMASK
#define PHMASK 0xFFFFFFFFu
#endif
#define EN(p) (((PHMASK) >> (p)) & 1u)
enum { PH_PREP = 0, PH_L0_F1, PH_L0_F2, PH_HG_IN, PH_H1, PH_H2, PH_H3, PH_HG_OUT, PH_L0_F3, PH_L0_F4, PH_L1_F1, PH_L1_F2, PH_FX_IN, PH_X2, PH_X3, PH_FX_OUT, PH_L1_F3, PH_L1_F4, NPH };

__device__ __forceinline__ void transpose_tile64(const float* W, int K, int ldn, bf16_t* WT, const float* gain, int k0, int n0, int drow0, LAS float* scr, int lane) {
    f32x2 v[32];
#pragma unroll
    for (int i = 0; i < 32; ++i) { const int kk = 2 * i + (lane >> 5); v[i] = *(const f32x2*)(W + (size_t)(k0 + kk) * ldn + n0 + 2 * (lane & 31)); }
#pragma unroll
    for (int i = 0; i < 32; ++i) { const int kk = 2 * i + (lane >> 5); const float gs = gain ? gain[k0 + kk] : 1.0f; scr[kk * 65 + 2 * (lane & 31)] = v[i][0] * gs; scr[kk * 65 + 2 * (lane & 31) + 1] = v[i][1] * gs; }
    asm volatile("s_waitcnt lgkmcnt(0)" ::: "memory");
    const int c = lane & 7;
#pragma unroll
    for (int j = 0; j < 8; ++j) { const int n = (lane >> 3) + 8 * j; const LAS float* p = scr + (8 * c) * 65 + n;
        u32x4 o; o.x = cvtpk(p[0 * 65], p[1 * 65]); o.y = cvtpk(p[2 * 65], p[3 * 65]); o.z = cvtpk(p[4 * 65], p[5 * 65]); o.w = cvtpk(p[6 * 65], p[7 * 65]);
        *(u32x4*)(WT + (size_t)(drow0 + n) * K + k0 + 8 * c) = o; }
    asm volatile("s_waitcnt lgkmcnt(0)" ::: "memory");
}
__device__ __forceinline__ void transpose_matrix(const float* W, int K, int N, int ldn, bf16_t* WT, const float* gain, int mode, int bitem, LAS float* scr, int wid, int lane) {
    const int nblk = N / 64, kg = bitem / nblk, nb = bitem % nblk, kbk = kg * 8 + wid;
    if (kbk * 64 >= K) return;
    const int n0 = 64 * nb; int drow0 = n0;
    if (mode == 1) { const int isb = n0 >= FF, f = n0 - isb * FF; drow0 = (f >> 7) * 256 + isb * 128 + (f & 127); }
    transpose_tile64(W, K, ldn, WT, gain, kbk * 64, n0, drow0, scr, lane);
}
__device__ __forceinline__ void phase_prep(const Args& a, LAS unsigned char* lds, int G) {
    const int tid = threadIdx.x, wid = tid >> 6, lane = tid & 63;
    unsigned char* ws = a.ws;
    LAS float* scr = (LAS float*)(lds + wid * 16640);
    const int gw = blockIdx.x * NWAVES + wid, NGW = G * NWAVES;
    constexpr int B_GU = (2 * FF / 64) * (DM / 512), B_DN = (DM / 64) * ((FF / 64 + 7) / 8), B_HI = (HG_N / 64) * (DM / 512), B_O = (DM / 64) * (DM / 512), B_FI = (8192 / 64) * (DM / 512);
    constexpr int NBITEMS = 4 * B_GU + 4 * B_DN + B_HI + B_O + B_FI + B_O;
    for (int it = blockIdx.x; it < NBITEMS; it += G) {
        int r = it;
        if (r < 4 * B_GU) { const int w = r / B_GU; r -= w * B_GU; const int layer = w >> 1, j = w & 1;
            transpose_matrix(a.w_gu + (size_t)w * DM * 2 * FF, DM, 2 * FF, 2 * FF, (bf16_t*)(ws + WS_WGU + w * SZ_WGU1), a.norm_g + (layer * 3 + (j ? 2 : 0)) * DM, 1, r, scr, wid, lane); continue; }
        r -= 4 * B_GU;
        if (r < 4 * B_DN) { const int w = r / B_DN; r -= w * B_DN;
            transpose_matrix(a.w_dn + (size_t)w * FF * DM, FF, DM, DM, (bf16_t*)(ws + WS_WDN + w * SZ_WDN1), nullptr, 0, r, scr, wid, lane); continue; }
        r -= 4 * B_DN;
        if (r < B_HI) { transpose_matrix(a.hg_w_in, DM, HG_N, HG_N, (bf16_t*)(ws + WS_WHI), a.norm_g + (0 * 3 + 1) * DM, 0, r, scr, wid, lane); continue; }
        r -= B_HI;
        if (r < B_O) { transpose_matrix(a.hg_w_out, DM, DM, DM, (bf16_t*)(ws + WS_WHO), nullptr, 0, r, scr, wid, lane); continue; }
        r -= B_O;
        if (r < B_FI) { transpose_matrix(a.fox_w_in, DM, 8192, FX_NREAL, (bf16_t*)(ws + WS_WFI), a.norm_g + (1 * 3 + 1) * DM, 0, r, scr, wid, lane); continue; }
        r -= B_FI;
        transpose_matrix(a.fox_w_out, DM, DM, DM, (bf16_t*)(ws + WS_WFO), nullptr, 0, r, scr, wid, lane);
    }
    { const int gt = blockIdx.x * NTHREADS + tid, NT = G * NTHREADS; bf16_t* WT = (bf16_t*)(ws + WS_WFI); const float* gain = a.norm_g + (1 * 3 + 1) * DM;
      for (int e = gt; e < 256 * DM; e += NT) { const int n = e / DM, k = e % DM; float v = 0.f; if (n < 16) v = a.fox_w_in[(size_t)k * FX_NREAL + 8192 + n] * gain[k];
          WT[(size_t)(8192 + n) * DM + k] = (bf16_t)(cvtpk(v, 0.f) & 0xffffu); }
      for (int e = gt; e < DM; e += NT) { const float l0 = a.lb_logits[e], l1 = a.lb_logits[DM + e], l2 = a.lb_logits[2 * DM + e]; const float mx = fmaxf(l0, fmaxf(l1, l2));
          const float e0 = fexp(l0 - mx), e1 = fexp(l1 - mx), e2 = fexp(l2 - mx); ((float*)(ws + WS_LB))[e] = e0 / (e0 + e1 + e2); }
      float* ssq = (float*)(ws + WS_SSQ);
      for (int e = gt; e < 5 * TR; e += NT) ssq[TR + e] = 0.f;
      }
    bf16_t* HB = (bf16_t*)(ws + WS_HB); float* ssq0 = (float*)(ws + WS_SSQ);
    for (int rg = blockIdx.x; rg < TR / 32; rg += G)
    for (int jr = 0; jr < 4; ++jr) { const int r = rg * 32 + wid * 4 + jr;
        const float* src = r >= ROW_X ? a.x + (size_t)(r - ROW_X) * DM : (r >= ROW_META ? a.meta + (size_t)(r - ROW_META) * DM : nullptr);
        float s = 0.f;
#pragma unroll
        for (int j = 0; j < 8; ++j) { f32x4 v = src ? *(const f32x4*)(src + j * 256 + lane * 4) : (f32x4){0.f, 0.f, 0.f, 0.f};
            u32x2 w; w.x = cvtpk(v[0], v[1]); w.y = cvtpk(v[2], v[3]); *(u32x2*)(HB + (size_t)r * DM + j * 256 + lane * 4) = w;
            s += (v[0] * v[0] + v[1] * v[1]) + (v[2] * v[2] + v[3] * v[3]); }
        s = wave_sum(s); if (lane == 0) ssq0[r] = s;
    }
}

#define TRRD2(d0, d1, a0_, a1_) asm volatile("ds_read_b64_tr_b16 %0, %2\n\tds_read_b64_tr_b16 %1, %3\n\ts_waitcnt lgkmcnt(0)" : "=&v"(d0), "=&v"(d1) : "v"(a0_), "v"(a1_) : "memory")
#define TRRD16(D, b0_, b1_) asm volatile( \
    "ds_read_b64_tr_b16 %0, %16\n\tds_read_b64_tr_b16 %1, %17\n\t" \
    "ds_read_b64_tr_b16 %2, %16 offset:32\n\tds_read_b64_tr_b16 %3, %17 offset:32\n\t" \
    "ds_read_b64_tr_b16 %4, %16 offset:64\n\tds_read_b64_tr_b16 %5, %17 offset:64\n\t" \
    "ds_read_b64_tr_b16 %6, %16 offset:96\n\tds_read_b64_tr_b16 %7, %17 offset:96\n\t" \
    "ds_read_b64_tr_b16 %8, %16 offset:128\n\tds_read_b64_tr_b16 %9, %17 offset:128\n\t" \
    "ds_read_b64_tr_b16 %10, %16 offset:160\n\tds_read_b64_tr_b16 %11, %17 offset:160\n\t" \
    "ds_read_b64_tr_b16 %12, %16 offset:192\n\tds_read_b64_tr_b16 %13, %17 offset:192\n\t" \
    "ds_read_b64_tr_b16 %14, %16 offset:224\n\tds_read_b64_tr_b16 %15, %17 offset:224\n\t" \
    "s_waitcnt lgkmcnt(0)" \
    : "=&v"(D[0]), "=&v"(D[1]), "=&v"(D[2]), "=&v"(D[3]), "=&v"(D[4]), "=&v"(D[5]), "=&v"(D[6]), "=&v"(D[7]), \
      "=&v"(D[8]), "=&v"(D[9]), "=&v"(D[10]), "=&v"(D[11]), "=&v"(D[12]), "=&v"(D[13]), "=&v"(D[14]), "=&v"(D[15]) \
    : "v"(b0_), "v"(b1_) : "memory")
constexpr int VPITCH = 288;
__device__ __forceinline__ bf16x8 join4(s16x4 a, s16x4 b) { return (bf16x8){a[0], a[1], a[2], a[3], b[0], b[1], b[2], b[3]}; }
__device__ __forceinline__ void stage_tile128(const bf16_t* src, LAS unsigned char* dst, int tid) {
#pragma unroll
    for (int k = 0; k < 4; ++k) { const int id = tid + NTHREADS * k, row = id >> 4, cc = id & 15; const u32x4 v = *(const u32x4*)(src + (size_t)row * DM + cc * 8); *(LAS u32x4*)(dst + row * VPITCH + cc * 16) = v; }
}
constexpr int SPITCH = 272;
__device__ __forceinline__ void stage_state(const bf16_t* src, LAS unsigned char* dst, int tid) {
#pragma unroll
    for (int k = 0; k < 4; ++k) { const int id = tid + NTHREADS * k, row = id >> 4, cc = id & 15; const u32x4 v = *(const u32x4*)(src + (size_t)row * HD + cc * 8); *(LAS u32x4*)(dst + row * SPITCH + cc * 16) = v; }
}
__device__ __forceinline__ void phase_h1(const Args& a, LAS unsigned char* lds, int G) {
    const int tid = threadIdx.x, wid = __builtin_amdgcn_readfirstlane(tid >> 6), lane = tid & 63, i16 = lane & 15, g = lane >> 4;
    unsigned char* ws = a.ws; float* LF = (float*)(ws + WS_LF); const bf16_t* KBp = (const bf16_t*)(ws + WS_KB); const bf16_t* VBp = (const bf16_t*)(ws + WS_VB);
    bf16_t* UT = (bf16_t*)(ws + WS_UT); float* DEC = (float*)(ws + WS_DEC);
    LAS unsigned char* Vs = lds; LAS unsigned char* Ks = lds + 128 * VPITCH; LAS float* tot = (LAS float*)(lds + 2 * 128 * VPITCH);
    for (int item = blockIdx.x; item < NCHUNK * NH; item += G) {
        const int c = item / NH, h = item % NH, R0 = c * 128;
        const int d = tid & 127, part = tid >> 7;
        float* lfp = LF + (size_t)(R0 + 32 * part) * DM + h * HD + d; const bf16_t* kp = KBp + (size_t)(R0 + 32 * part) * DM + h * HD + d;
        float bl[32]; float run = 0.f;
#pragma unroll
        for (int i = 0; i < 32; ++i) { run += lfp[(size_t)i * DM]; bl[i] = run; }
        tot[part * 128 + d] = run;
        stage_tile128(VBp + (size_t)R0 * DM + h * HD, Vs, tid);
        __syncthreads();
        const float t0 = tot[d], t1 = tot[128 + d], t2 = tot[256 + d], t3 = tot[384 + d];
        const float off = part == 0 ? 0.f : part == 1 ? t0 : part == 2 ? t0 + t1 : t0 + t1 + t2; const float blast = (t0 + t1) + (t2 + t3);
#pragma unroll
        for (int i = 0; i < 32; ++i) { const float b = bl[i] + off; lfp[(size_t)i * DM] = b; const float kv = bf2f(kp[(size_t)i * DM]) * fexp(blast - b);
            *(LAS bf16_t*)(Ks + (32 * part + i) * VPITCH + d * 2) = (bf16_t)(cvtpk(kv, 0.f) & 0xffffu); }
        if (part == 0) DEC[(size_t)(c * NH + h) * HD + d] = fexp(blast);
        __syncthreads();
        f32x4 acc[8];
#pragma unroll
        for (int n = 0; n < 8; ++n) acc[n] = (f32x4){0.f, 0.f, 0.f, 0.f};
        const int rsel = 4 * g + (i16 >> 2), csel = 4 * (i16 & 3);
#pragma unroll
        for (int ks = 0; ks < 4; ++ks) { const int s0 = 32 * ks;
            s16x4 a0, a1; TRRD2(a0, a1, (unsigned)(uintptr_t)(Vs + (s0 + rsel) * VPITCH + (16 * wid + csel) * 2), (unsigned)(uintptr_t)(Vs + (s0 + 16 + rsel) * VPITCH + (16 * wid + csel) * 2));
            const bf16x8 af = join4(a0, a1);
            s16x4 bd[16]; TRRD16(bd, (unsigned)(uintptr_t)(Ks + (s0 + rsel) * VPITCH + csel * 2), (unsigned)(uintptr_t)(Ks + (s0 + 16 + rsel) * VPITCH + csel * 2));
#pragma unroll
            for (int n = 0; n < 8; ++n) acc[n] = __builtin_amdgcn_mfma_f32_16x16x32_bf16(af, join4(bd[2 * n], bd[2 * n + 1]), acc[n], 0, 0, 0); }
        bf16_t* up = UT + ((size_t)(c * NH + h) * HD + 16 * wid + 4 * g) * HD + i16;
#pragma unroll
        for (int n = 0; n < 8; ++n)
#pragma unroll
            for (int r = 0; r < 4; ++r) up[(size_t)r * HD + 16 * n] = (bf16_t)(cvtpk(acc[n][r], 0.f) & 0xffffu);
        __syncthreads();
    }
}
__device__ __forceinline__ void phase_h2(const Args& a, int G) {
    unsigned char* ws = a.ws; const bf16_t* UT = (const bf16_t*)(ws + WS_UT); const float* DEC = (const float*)(ws + WS_DEC); bf16_t* ST = (bf16_t*)(ws + WS_ST);
    for (int e = blockIdx.x * NTHREADS + threadIdx.x; e < NH * HD * 64; e += G * NTHREADS) {
        const int hv = e >> 6, dp = e & 63, h = hv >> 7, v = hv & 127, d = 2 * dp;
        f32x2 S = {0.f, 0.f};
        for (int c0 = 0; c0 < NCHUNK; c0 += 10) {
            f32x2 u[10], dc[10];
#pragma unroll
            for (int k = 0; k < 10; ++k) { const int c = c0 + k; { const unsigned uw = *(const unsigned*)(UT + ((size_t)(c * NH + h) * HD + v) * HD + d); u[k] = (f32x2){bflo(uw), bfhi(uw)}; } dc[k] = *(const f32x2*)(DEC + (size_t)(c * NH + h) * HD + d); }
#pragma unroll
            for (int k = 0; k < 10; ++k) { const int c = c0 + k; *(unsigned*)(ST + ((size_t)(c * NH + h) * HD + v) * HD + d) = cvtpk(S[0], S[1]); S = dc[k] * S + u[k]; }
        }
    }
}
__device__ __forceinline__ void phase_h3(const Args& a, LAS unsigned char* lds, int G) {
    const int tid = threadIdx.x, wid = __builtin_amdgcn_readfirstlane(tid >> 6), lane = tid & 63, i16 = lane & 15, g = lane >> 4;
    unsigned char* ws = a.ws; const float* Bb = (const float*)(ws + WS_LF); const bf16_t* QBp = (const bf16_t*)(ws + WS_QB); const bf16_t* KBp = (const bf16_t*)(ws + WS_KB);
    const bf16_t* VBp = (const bf16_t*)(ws + WS_VB); const bf16_t* GBp = (const bf16_t*)(ws + WS_GB); const bf16_t* ST = (const bf16_t*)(ws + WS_ST); bf16_t* OG = (bf16_t*)(ws + WS_OG);
    constexpr int NPAIR = (NCHUNK - 2) * NH / 2;
    for (int pw = blockIdx.x; pw < NPAIR + NH; pw += G) {
        const bool metaitem = pw >= NPAIR;
        { const int it0 = metaitem ? NH + (pw - NPAIR) : 2 * NH + 2 * pw; const int c0 = it0 / NH, h0 = it0 % NH;
          stage_tile128(VBp + (size_t)(c0 * 128) * DM + h0 * HD, lds, tid);
          stage_state(ST + (size_t)(c0 * NH + h0) * HD * HD, lds + 2 * 128 * VPITCH, tid);
          if (!metaitem) { const int it1 = it0 + 1, c1 = it1 / NH, h1 = it1 % NH; stage_tile128(VBp + (size_t)(c1 * 128) * DM + h1 * HD, lds + 128 * VPITCH, tid);
              stage_state(ST + (size_t)(c1 * NH + h1) * HD * HD, lds + 2 * 128 * VPITCH + 128 * SPITCH, tid); } }
        __syncthreads();
      for (int half = 0; half < (metaitem ? 1 : 2); ++half) {
        const int item = metaitem ? NH + (pw - NPAIR) : 2 * NH + 2 * pw + half;
        const int c = item / NH, h = item % NH, R0 = c * 128;
        const int I = metaitem ? 7 : (half ? 7 - wid : wid);
        if (metaitem && wid != 7) continue;
        LAS unsigned char* Vs = lds + half * (128 * VPITCH);
        const size_t hb = (size_t)h * HD;
        f32x4 br[4][2];
#pragma unroll
        for (int ks = 0; ks < 4; ++ks) { const float* p = Bb + (size_t)(R0 + 16 * I - 1) * DM + hb + 32 * ks + 8 * g;
            if (I > 0) { br[ks][0] = *(const f32x4*)p; br[ks][1] = *(const f32x4*)(p + 4); } else { br[ks][0] = (f32x4){0.f, 0.f, 0.f, 0.f}; br[ks][1] = br[ks][0]; } }
        bf16x8 qf[4], qh[4];
        { const size_t ro = (size_t)(R0 + 16 * I + i16) * DM + hb + 8 * g;
#pragma unroll
          for (int ks = 0; ks < 4; ++ks) { const u32x4 q8 = *(const u32x4*)(QBp + ro + 32 * ks); const f32x4 b0 = *(const f32x4*)(Bb + ro + 32 * ks), b1 = *(const f32x4*)(Bb + ro + 32 * ks + 4);
              float qv[8] = {bflo(q8.x), bfhi(q8.x), bflo(q8.y), bfhi(q8.y), bflo(q8.z), bfhi(q8.z), bflo(q8.w), bfhi(q8.w)}; float x1[8], x2[8];
#pragma unroll
              for (int j = 0; j < 8; ++j) { const float bt = j < 4 ? b0[j] : b1[j - 4], rf = j < 4 ? br[ks][0][j] : br[ks][1][j - 4]; x1[j] = qv[j] * fexp(bt - rf); x2[j] = qv[j] * fexp(bt); }
              u32x4 w1 = {cvtpk(x1[0], x1[1]), cvtpk(x1[2], x1[3]), cvtpk(x1[4], x1[5]), cvtpk(x1[6], x1[7])}; u32x4 w2 = {cvtpk(x2[0], x2[1]), cvtpk(x2[2], x2[3]), cvtpk(x2[4], x2[5]), cvtpk(x2[6], x2[7])};
              qf[ks] = *reinterpret_cast<bf16x8*>(&w1); qh[ks] = *reinterpret_cast<bf16x8*>(&w2); } }
        f32x4 o[8];
#pragma unroll
        for (int n = 0; n < 8; ++n) o[n] = (f32x4){0.f, 0.f, 0.f, 0.f};
        { const LAS unsigned char* sp = lds + 2 * 128 * VPITCH + half * (128 * SPITCH) + i16 * SPITCH + 16 * g;
#pragma unroll
          for (int ks = 0; ks < 4; ++ks)
#pragma unroll
              for (int n = 0; n < 8; ++n) { const bf16x8 sf = *(const LAS bf16x8*)(sp + (16 * n) * SPITCH + 64 * ks); o[n] = __builtin_amdgcn_mfma_f32_16x16x32_bf16(qh[ks], sf, o[n], 0, 0, 0); } }
        const int rsel = 4 * g + (i16 >> 2), csel = 4 * (i16 & 3);
        u32x2 pA = {0u, 0u};
        for (int J = metaitem ? 7 : 0; J <= I; ++J) {
            f32x4 sacc = {0.f, 0.f, 0.f, 0.f};
            const size_t ro = (size_t)(R0 + 16 * J + i16) * DM + hb + 8 * g;
#pragma unroll
            for (int ks = 0; ks < 4; ++ks) { const u32x4 k8 = *(const u32x4*)(KBp + ro + 32 * ks); const f32x4 b0 = *(const f32x4*)(Bb + ro + 32 * ks), b1 = *(const f32x4*)(Bb + ro + 32 * ks + 4);
                float kv[8] = {bflo(k8.x), bfhi(k8.x), bflo(k8.y), bfhi(k8.y), bflo(k8.z), bfhi(k8.z), bflo(k8.w), bfhi(k8.w)}; float x1[8];
#pragma unroll
                for (int j = 0; j < 8; ++j) { const float bs = j < 4 ? b0[j] : b1[j - 4], rf = j < 4 ? br[ks][0][j] : br[ks][1][j - 4]; x1[j] = kv[j] * fexp(fminf(rf - bs, 80.f)); }
                u32x4 w1 = {cvtpk(x1[0], x1[1]), cvtpk(x1[2], x1[3]), cvtpk(x1[4], x1[5]), cvtpk(x1[6], x1[7])};
                sacc = __builtin_amdgcn_mfma_f32_16x16x32_bf16(*reinterpret_cast<bf16x8*>(&w1), qf[ks], sacc, 0, 0, 0); }
            if (J == I) {
#pragma unroll
                for (int r = 0; r < 4; ++r) if (4 * g + r > i16) sacc[r] = 0.f; }
            u32x2 pk = {cvtpk(sacc[0], sacc[1]), cvtpk(sacc[2], sacc[3])};
            if ((J & 1) == 0 && J < I) { pA = pk; continue; }
            u32x2 pB; int sA, sB;
            if (J & 1) { pB = pk; sA = 16 * (J - 1); sB = 16 * J; } else { pA = pk; pB = (u32x2){0u, 0u}; sA = 16 * J; sB = 16 * J; }
            u32x4 pw = {pA.x, pA.y, pB.x, pB.y}; const bf16x8 pf = *reinterpret_cast<bf16x8*>(&pw);
            s16x4 vd[16]; TRRD16(vd, (unsigned)(uintptr_t)(Vs + (sA + rsel) * VPITCH + csel * 2), (unsigned)(uintptr_t)(Vs + (sB + rsel) * VPITCH + csel * 2));
#pragma unroll
            for (int n = 0; n < 8; ++n) o[n] = __builtin_amdgcn_mfma_f32_16x16x32_bf16(pf, join4(vd[2 * n], vd[2 * n + 1]), o[n], 0, 0, 0);
        }
        float rn[4];
#pragma unroll
        for (int r = 0; r < 4; ++r) { float s = 0.f;
#pragma unroll
            for (int n = 0; n < 8; ++n) s += o[n][r] * o[n][r];
            s += __shfl_xor(s, 1); s += __shfl_xor(s, 2); s += __shfl_xor(s, 4); s += __shfl_xor(s, 8);
            rn[r] = __builtin_amdgcn_rsqf(s * (1.0f / HD) + RMS_EPS); }
#pragma unroll
        for (int n = 0; n < 8; ++n) { const float on = a.hg_onorm[16 * n + i16];
#pragma unroll
            for (int r = 0; r < 4; ++r) { const size_t off = (size_t)(R0 + 16 * I + 4 * g + r) * DM + hb + 16 * n + i16;
                const float val = o[n][r] * rn[r] * on * bf2f(GBp[off]); OG[off] = (bf16_t)(cvtpk(val, 0.f) & 0xffffu); } }
      }
        __syncthreads();
    }
}

__device__ __forceinline__ void phase_x2(const Args& a, int G) {
    const int tid = threadIdx.x, wid = tid >> 6, lane = tid & 63;
    unsigned char* ws = a.ws;
    const float* LFX = (const float*)(ws + WS_LFX); float* LOC = (float*)(ws + WS_LOC); float* SEG = (float*)(ws + WS_SEG);
    const int gw = blockIdx.x * NWAVES + wid, NGW = G * NWAVES;
    if (gw < NCHUNK) {
        const int sg = gw, hh = lane & 15, part = lane >> 4; float v[32]; float run = 0.f;
#pragma unroll
        for (int i = 0; i < 32; ++i) { const int r = sg * 128 + part * 32 + i; const float x = r >= ROW_META ? LFX[(size_t)r * 16 + hh] : 0.f; run += x; v[i] = run; }
        const float t0 = __shfl(run, hh), t1 = __shfl(run, 16 + hh), t2 = __shfl(run, 32 + hh), t3 = __shfl(run, 48 + hh);
        const float off = part == 0 ? 0.f : part == 1 ? t0 : part == 2 ? t0 + t1 : t0 + t1 + t2;
#pragma unroll
        for (int i = 0; i < 32; ++i) LOC[(size_t)(sg * 128 + part * 32 + i) * 16 + hh] = v[i] + off;
        if (part == 0) SEG[sg * 16 + hh] = (t0 + t1) + (t2 + t3);
    }
    bf16_t* KBp = (bf16_t*)(ws + WS_KB);
    for (int r = ROW_META + gw; r < TR; r += NGW) {
#pragma unroll
        for (int p = 0; p < 4; ++p) { bf16_t* ptr = KBp + (size_t)r * DM + p * 512 + lane * 8; const u32x4 w = *(const u32x4*)ptr;
            float x[8] = {bflo(w.x), bfhi(w.x), bflo(w.y), bfhi(w.y), bflo(w.z), bfhi(w.z), bflo(w.w), bfhi(w.w)}; float sk = 0.f;
#pragma unroll
            for (int j = 0; j < 8; ++j) sk += x[j] * x[j];
            sk += __shfl_xor(sk, 1); sk += __shfl_xor(sk, 2); sk += __shfl_xor(sk, 4); sk += __shfl_xor(sk, 8);
            const float rn = __builtin_amdgcn_rsqf(sk * (1.0f / HD) + RMS_EPS); const float* gp = a.fox_knorm + (lane & 15) * 8;
#pragma unroll
            for (int j = 0; j < 8; ++j) x[j] = x[j] * rn * gp[j];
            u32x4 o = {cvtpk(x[0], x[1]), cvtpk(x[2], x[3]), cvtpk(x[4], x[5]), cvtpk(x[6], x[7])}; *(u32x4*)ptr = o; }
    }
}

namespace att {
constexpr float SCALE = 0.08838834764831845f, INV_SCALE = 11.313708498984761f, THR = 8.f;
constexpr int QBLK = 32, KVBLK = 64, QB = 256, SHM_V = KVBLK * HD * 2, SHM_K = KVBLK * HD * 2;
#define KSWZ(row, colB) ((row) * 256 + ((colB) ^ (((row) & 7) << 4)))
#define SBAR() __builtin_amdgcn_sched_barrier(0)
__device__ __forceinline__ int v_st(int k, int c) { const int kk = (k & ~0xC) | ((k & 4) << 1) | ((k & 8) >> 1); return ((kk >> 3) * 4 + (c >> 5)) * 512 + ((kk & 7) * 32 + (c & 31)) * 2; }
__device__ __forceinline__ int v_rd_base(int lane) { return ((lane & 3) << 3) | (((lane >> 2) & 3) << 6) | (((lane >> 4) & 1) << 5) | (((lane >> 5) & 1) << 8); }
constexpr int v_rd_off(int d0, int ks, int half) { return d0 * 512 + ks * 4096 + half * 2048; }
__device__ __forceinline__ int crow(int r, int hi) { return (r & 3) + 8 * (r >> 2) + 4 * hi; }
__device__ __forceinline__ void mask_tile(f32x16& p0, f32x16& p1, int dq, unsigned W) {
    const float NEG = -__builtin_inff();
#pragma unroll
    for (int r = 0; r < 16; ++r) { const int c = (r & 3) + 8 * (r >> 2);
        if ((unsigned)(dq - c) >= W) p0[r] = NEG;
        if ((unsigned)(dq - c - 32) >= W) p1[r] = NEG; }
}
__device__ __forceinline__ void partialSM(f32x16& p0, f32x16& p1, float& m_reg, float& mn, float& alpha) {
    float pmax = p0[0];
#pragma unroll
    for (int r = 1; r < 16; ++r) pmax = fmaxf(pmax, p0[r]);
#pragma unroll
    for (int r = 0; r < 16; ++r) pmax = fmaxf(pmax, p1[r]);
    { auto rr = __builtin_amdgcn_permlane32_swap(__float_as_uint(pmax), __float_as_uint(pmax), false, false); pmax = fmaxf(__uint_as_float(rr[0]), __uint_as_float(rr[1])); }
    constexpr float C2 = 1.4426950408889634f * SCALE;
    if (__builtin_expect(__all((pmax - m_reg) * SCALE <= THR), 1)) { mn = m_reg; alpha = 1.f; }
    else { mn = fmaxf(m_reg, pmax); alpha = __builtin_amdgcn_exp2f((m_reg - mn) * C2); m_reg = mn; }
    const float mnL = -mn * C2;
#pragma unroll
    for (int r = 0; r < 16; ++r) p0[r] = fmaf(p0[r], C2, mnL);
#pragma unroll
    for (int r = 0; r < 16; ++r) p1[r] = fmaf(p1[r], C2, mnL);
#pragma unroll
    for (int r = 0; r < 16; ++r) p0[r] = __builtin_amdgcn_exp2f(p0[r]);
}
__device__ __forceinline__ void finishSM(f32x16& p0, f32x16& p1, float alpha, float& l_reg, bf16x8& pa0, bf16x8& pa1, bf16x8& pa2, bf16x8& pa3) {
#pragma unroll
    for (int r = 0; r < 16; ++r) p1[r] = __builtin_amdgcn_exp2f(p1[r]);
    float ps = 0;
#pragma unroll
    for (int r = 0; r < 16; ++r) ps += p0[r];
#pragma unroll
    for (int r = 0; r < 16; ++r) ps += p1[r];
    { auto rr = __builtin_amdgcn_permlane32_swap(__float_as_uint(ps), __float_as_uint(ps), false, false); ps = __uint_as_float(rr[0]) + __uint_as_float(rr[1]); }
    l_reg = l_reg * alpha + ps;
#define PK4(P, B_, OUT) do { unsigned a0 = cvtpk(P[B_+0], P[B_+1]), a1 = cvtpk(P[B_+2], P[B_+3]); unsigned b0 = cvtpk(P[B_+4], P[B_+5]), b1 = cvtpk(P[B_+6], P[B_+7]); \
        auto r0 = __builtin_amdgcn_permlane32_swap(a0, b0, false, false); auto r1 = __builtin_amdgcn_permlane32_swap(a1, b1, false, false); \
        u32x4 w = {r0[0], r1[0], r0[1], r1[1]}; OUT = *reinterpret_cast<bf16x8*>(&w); } while (0)
    PK4(p0, 0, pa0); PK4(p0, 8, pa1); PK4(p1, 0, pa2); PK4(p1, 8, pa3);
#undef PK4
}
__device__ __forceinline__ void qkt(f32x16& p0, f32x16& p1, const char* Kb, int r32, int hi, const bf16x8* qr) {
    p0 = f32x16{}; p1 = f32x16{};
    const char* kb[4];
#pragma unroll
    for (int dd = 0; dd < 4; ++dd) kb[dd] = Kb + KSWZ(r32, (dd * 16 + hi * 8) * 2);
#pragma unroll
    for (int d0 = 0; d0 < 8; ++d0) { const char* ap = kb[d0 & 3] + (d0 >> 2) * 128;
        bf16x8 b0 = *reinterpret_cast<const bf16x8*>(ap);
        bf16x8 b1 = *reinterpret_cast<const bf16x8*>(ap + 32 * 256);
        p0 = __builtin_amdgcn_mfma_f32_32x32x16_bf16(b0, qr[d0], p0, 0, 0, 0);
        p1 = __builtin_amdgcn_mfma_f32_32x32x16_bf16(b1, qr[d0], p1, 0, 0, 0); }
}
__device__ __forceinline__ void pv_tile(f32x16* o, int vb0, bf16x8 pa0, bf16x8 pa1, bf16x8 pa2, bf16x8 pa3) {
#define TRRDO(dst, off) asm volatile("ds_read_b64_tr_b16 %0, %1 offset:%2" : "=&v"(dst) : "v"(vb0), "i"(off) : "memory")
#define PV_D0(d0) do { s16x4 l0, l1, l2, l3, h0, h1, h2, h3; constexpr int b_ = v_rd_off(d0, 0, 0); \
        TRRDO(l0, b_); TRRDO(h0, b_ + 2048); TRRDO(l1, b_ + 4096); TRRDO(h1, b_ + 6144); TRRDO(l2, b_ + 8192); TRRDO(h2, b_ + 10240); TRRDO(l3, b_ + 12288); TRRDO(h3, b_ + 14336); \
        asm volatile("s_waitcnt lgkmcnt(0)" ::: "memory"); SBAR(); \
        o[d0] = __builtin_amdgcn_mfma_f32_32x32x16_bf16(pa0, (bf16x8){l0[0], l0[1], l0[2], l0[3], h0[0], h0[1], h0[2], h0[3]}, o[d0], 0, 0, 0); \
        o[d0] = __builtin_amdgcn_mfma_f32_32x32x16_bf16(pa1, (bf16x8){l1[0], l1[1], l1[2], l1[3], h1[0], h1[1], h1[2], h1[3]}, o[d0], 0, 0, 0); \
        o[d0] = __builtin_amdgcn_mfma_f32_32x32x16_bf16(pa2, (bf16x8){l2[0], l2[1], l2[2], l2[3], h2[0], h2[1], h2[2], h2[3]}, o[d0], 0, 0, 0); \
        o[d0] = __builtin_amdgcn_mfma_f32_32x32x16_bf16(pa3, (bf16x8){l3[0], l3[1], l3[2], l3[3], h3[0], h3[1], h3[2], h3[3]}, o[d0], 0, 0, 0); } while (0)
    PV_D0(0); PV_D0(1); PV_D0(2); PV_D0(3);
#undef PV_D0
#undef TRRDO
}
}

__device__ __forceinline__ void phase_x3(const Args& a, unsigned char* ldsg, int G) {
    using namespace att;
    const int tid = threadIdx.x, wid = __builtin_amdgcn_readfirstlane(tid >> 6), lane = tid & 63, r32 = lane & 31, hi = lane >> 5;
    unsigned char* ws = a.ws; const bf16_t* QBp = (const bf16_t*)(ws + WS_QB); const bf16_t* KBp = (const bf16_t*)(ws + WS_KB); const bf16_t* VBp = (const bf16_t*)(ws + WS_VB);
    const bf16_t* GBp = (const bf16_t*)(ws + WS_GB); bf16_t* OG = (bf16_t*)(ws + WS_OG); const float* LOC = (const float*)(ws + WS_LOC); const float* SEG = (const float*)(ws + WS_SEG); const float* RKp = (const float*)(ws + WS_RK);
    char* V_lds = (char*)ldsg; char* K_lds = (char*)ldsg + 2 * SHM_V;
    float* wsf = (float*)(ldsg + 2 * SHM_V + 2 * SHM_K) + wid * 64; float* li_l = wsf, * al_l = wsf + 32;
    float* ck_l = (float*)(ldsg + 2 * SHM_V + 2 * SHM_K + 2048);
    float* rk_l = ck_l + 128;
    float* cseg = rk_l + 128;
    int* misc = (int*)(cseg + 136);
    float* g2_l = (float*)(misc + 4);
    if (tid < HD) g2_l[tid] = a.fox_qnorm[tid];
    int ksr[2], ksc[2], vsr[2], vsc[2];
#pragma unroll
    for (int i = 0; i < 2; ++i) { const int q = i * 512 + tid; const int row = q >> 4, cpos = q & 15; ksr[i] = row; ksc[i] = ((cpos ^ (row & 7)) * 8);
        const int st = q >> 5, w = q & 31, kkl = w >> 2, cch = w & 3, kk = (st >> 2) * 8 + kkl, key = (kk & ~0xC) | ((kk & 4) << 1) | ((kk & 8) >> 1); vsr[i] = key; vsc[i] = (st & 3) * 32 + cch * 8; }
    LAS unsigned char* ldsl = (LAS unsigned char*)ldsg;
    const int vbase = (int)(uintptr_t)V_lds + v_rd_base(lane);
    float gq = 0.f, gk = 0.f; for (int i = 0; i < HD; ++i) { gq = fmaxf(gq, fabsf(a.fox_qnorm[i])); gk = fmaxf(gk, fabsf(a.fox_knorm[i])); }
    const float THRESH = 105.0f + 2.0f * (gq * gk * (float)HD * SCALE) + 1.0f;
    const int NITEM = (TR / QB - 1) * NH;
    int h_scanned = -1;
    for (int item = blockIdx.x; item < NITEM; item += G) {
        const int qb = (TR / QB) - 1 - item / NH, h = item % NH, R0 = qb * QB; const size_t hb = (size_t)h * HD;
        __syncthreads();
        if (wid == 0 && h != h_scanned) {
            float run = 0.f;
            for (int s0 = 0; s0 < NCHUNK; s0 += 64) { const int sg = s0 + lane; float v = sg < NCHUNK ? SEG[sg * 16 + h] : 0.f; float x = v;
#pragma unroll
                for (int o = 1; o < 64; o <<= 1) { const float y = __shfl_up(x, o); if (lane >= o) x += y; }
                if (sg < NCHUNK) cseg[sg] = run + x - v; run += __shfl(x, 63); }
        }
        h_scanned = h;
        if (tid == 0) misc[0] = 1 << 30;
        __syncthreads();
        const int j_hi = R0 / KVBLK + 4;
        { const int rq = R0 < ROW_META ? ROW_META : R0; const float c0 = cseg[rq >> 7] + LOC[(size_t)rq * 16 + h];
          if (tid >= 3 && tid < j_hi) { const int e = tid * KVBLK + 63; const float ce = cseg[e >> 7] + LOC[(size_t)e * 16 + h]; if (c0 - ce >= -THRESH) atomicMin(misc, tid); } }
        __syncthreads();
        const int j_lo = misc[0], NT = j_hi - j_lo;
        const int row = R0 + wid * QBLK + r32;
        bf16x8 qr[8];
        { float sq = 0.f;
#pragma unroll
          for (int d0 = 0; d0 < 8; ++d0) { const u32x4 w = *(const u32x4*)(QBp + (size_t)row * DM + hb + d0 * 16 + hi * 8);
              const float x[8] = {bflo(w.x), bfhi(w.x), bflo(w.y), bfhi(w.y), bflo(w.z), bfhi(w.z), bflo(w.w), bfhi(w.w)};
#pragma unroll
              for (int j = 0; j < 8; ++j) sq += x[j] * x[j]; }
          { auto rr = __builtin_amdgcn_permlane32_swap(__float_as_uint(sq), __float_as_uint(sq), false, false); sq = __uint_as_float(rr[0]) + __uint_as_float(rr[1]); }
          const float rq = __builtin_amdgcn_rsqf(sq * (1.0f / HD) + RMS_EPS);
          asm volatile("" ::: "memory");
#pragma unroll
          for (int d0 = 0; d0 < 8; ++d0) { const u32x4 w = *(const u32x4*)(QBp + (size_t)row * DM + hb + d0 * 16 + hi * 8);
              const f32x4 g0 = *(const f32x4*)(g2_l + d0 * 16 + hi * 8), g1 = *(const f32x4*)(g2_l + d0 * 16 + hi * 8 + 4);
              const f32x4 x0 = {bflo(w.x), bfhi(w.x), bflo(w.y), bfhi(w.y)}, x1 = {bflo(w.z), bfhi(w.z), bflo(w.w), bfhi(w.w)};
              qr[d0] = pack8(x0 * rq * g0, x1 * rq * g1); } }
        const int qlo = R0 + wid * QBLK, qm = row - 4 * hi;
        const unsigned Wm = row >= ROW_META ? (unsigned)(row - (ROW_META - 1)) : 1u;
        float m_reg = -1e30f, l_reg = 0.f; f32x16 o[4] = {};
        float st_c = 0.f;
#define KDMA(kb_, bf) do { _Pragma("unroll") for (int i_ = 0; i_ < 2; ++i_) \
        __builtin_amdgcn_global_load_lds((const unsigned*)(KBp + (size_t)((kb_) + ksr[i_]) * DM + hb + ksc[i_]), (LAS unsigned*)(ldsl + 2 * SHM_V + (bf) * SHM_K + (i_ * 512 + wid * 64) * 16), 16, 0, 0); } while (0)
#define VDMA(kb_, bf) do { _Pragma("unroll") for (int i_ = 0; i_ < 2; ++i_) \
        __builtin_amdgcn_global_load_lds((const unsigned*)(VBp + (size_t)((kb_) + vsr[i_]) * DM + hb + vsc[i_]), (LAS unsigned*)(ldsl + (bf) * SHM_V + (i_ * 512 + wid * 64) * 16), 16, 0, 0); } while (0)
#define CLOAD(kb_) do { if (tid < 64) { st_c = (cseg[((kb_) + tid) >> 7] + LOC[(size_t)((kb_) + tid) * 16 + h]) * INV_SCALE; } } while (0)
#define CWRITE(bf) do { if (tid < 64) { ck_l[(bf) * 64 + tid] = st_c; } } while (0)
#define BIASMASK(P0, P1, t_, bf) do { const int kb_ = (j_lo + (t_)) * KVBLK; const float* ckb = ck_l + (bf) * 64 + 4 * hi; \
        _Pragma("unroll") for (int gI = 0; gI < 4; ++gI) { { const f32x4 c0 = *(const f32x4*)(ckb + 8 * gI); \
            _Pragma("unroll") for (int j = 0; j < 4; ++j) P0[4 * gI + j] -= c0[j]; } SBAR(); \
            { const f32x4 c1 = *(const f32x4*)(ckb + 32 + 8 * gI); \
            _Pragma("unroll") for (int j = 0; j < 4; ++j) P1[4 * gI + j] -= c1[j]; } SBAR(); } \
        if (kb_ + KVBLK - 1 > qlo || kb_ < ROW_META) mask_tile(P0, P1, qm - kb_, Wm); } while (0)
        KDMA(j_lo * KVBLK, 0); VDMA(j_lo * KVBLK, 0); CLOAD(j_lo * KVBLK); CWRITE(0);
        if (NT > 1) { KDMA((j_lo + 1) * KVBLK, 1); CLOAD((j_lo + 1) * KVBLK); CWRITE(1); }
        asm volatile("s_waitcnt vmcnt(0)" ::: "memory");
        __syncthreads();
        f32x16 pA0, pA1, pB0, pB1;
        qkt(pA0, pA1, K_lds, r32, hi, qr); BIASMASK(pA0, pA1, 0, 0);
        __syncthreads();
#define STEP(X0, X1, Y0, Y1, t_, par) do { \
        if ((t_) + 2 < NT) { KDMA((j_lo + (t_) + 2) * KVBLK, par); CLOAD((j_lo + (t_) + 2) * KVBLK); } \
        if ((t_) + 1 < NT) { VDMA((j_lo + (t_) + 1) * KVBLK, (par) ^ 1); qkt(Y0, Y1, K_lds + ((par) ^ 1) * SHM_K, r32, hi, qr); } \
        float mn, alpha; bf16x8 pa0, pa1, pa2, pa3; \
        partialSM(X0, X1, m_reg, mn, alpha); \
        if (__any(alpha < 1.f)) { if (hi == 0) al_l[r32] = alpha; asm volatile("s_waitcnt lgkmcnt(0)" ::: "memory"); \
            _Pragma("unroll") for (int d_ = 0; d_ < 4; ++d_) _Pragma("unroll") for (int r = 0; r < 16; ++r) o[d_][r] *= al_l[crow(r, hi)]; } \
        finishSM(X0, X1, alpha, l_reg, pa0, pa1, pa2, pa3); \
        pv_tile(o, vbase + (par) * SHM_V, pa0, pa1, pa2, pa3); \
        if ((t_) + 1 < NT) BIASMASK(Y0, Y1, (t_) + 1, (par) ^ 1); \
        if ((t_) + 2 < NT) CWRITE(par); \
        asm volatile("s_waitcnt vmcnt(0)" ::: "memory"); \
        __syncthreads(); } while (0)
        for (int t = 0; t < NT; t += 2) {
            STEP(pA0, pA1, pB0, pB1, t, 0);
            if (t + 1 < NT) STEP(pB0, pB1, pA0, pA1, t + 1, 1);
        }
#undef STEP
#undef BIASMASK
#undef KDMA
#undef VDMA
#undef CLOAD
#undef CWRITE
        if (hi == 0) li_l[r32] = l_reg; asm volatile("s_waitcnt lgkmcnt(0)" ::: "memory");
#pragma unroll
        for (int r = 0; r < 16; ++r) { const int orow = crow(r, hi); const float rli = __builtin_amdgcn_rcpf(li_l[orow]); const int grow = R0 + wid * QBLK + orow; const size_t off = (size_t)grow * DM + hb;
#pragma unroll
            for (int d0 = 0; d0 < 4; ++d0) { float v = o[d0][r] * rli * bf2f(GBp[off + d0 * 32 + r32]); if (grow < ROW_META) v = 0.f;
                const float vn = __shfl_xor(v, 1);
                if ((r32 & 1) == 0) *(unsigned*)(OG + off + d0 * 32 + r32) = cvtpk(v, vn); } }
    }
}


__device__ __forceinline__ bf16_t tobf(float v) { return (bf16_t)(cvtpk(v, 0.f) & 0xffffu); }
template <int NG, class Epi>
__device__ __forceinline__ void skinny_phase(LAS unsigned char* lds, const bf16_t* A16, const bf16_t* Bt, int K, int ntask, const Epi& E, int G, int first = 0) {
    const int tid = threadIdx.x, wid = __builtin_amdgcn_readfirstlane(tid >> 6), lane = tid & 63, c16 = lane & 15, g = lane >> 4;
    LAS f32x4* red = (LAS f32x4*)lds;
    const int nks = K / 32;
    if ((int)blockIdx.x < first) return;
    for (int task = blockIdx.x - first; task < ntask; task += G - first) {
        f32x4 acc[NG][4];
        const bf16_t* ap = A16 + (size_t)c16 * K + 8 * g; const bf16_t* bp[NG];
#pragma unroll
        for (int ng = 0; ng < NG; ++ng) { bp[ng] = Bt + (size_t)(E.brow(task, ng) + c16) * K + 8 * g;
#pragma unroll
            for (int nt = 0; nt < 4; ++nt) acc[ng][nt] = (f32x4){0.f, 0.f, 0.f, 0.f}; }
#pragma unroll 8
        for (int ks = wid; ks < nks; ks += 8) { const bf16x8 av = *(const bf16x8*)(ap + 32 * ks);
#pragma unroll
            for (int ng = 0; ng < NG; ++ng)
#pragma unroll
                for (int nt = 0; nt < 4; ++nt) { const bf16x8 bv = *(const bf16x8*)(bp[ng] + (size_t)(16 * nt) * K + 32 * ks); acc[ng][nt] = __builtin_amdgcn_mfma_f32_16x16x32_bf16(av, bv, acc[ng][nt], 0, 0, 0); } }
#pragma unroll
        for (int ng = 0; ng < NG; ++ng)
#pragma unroll
            for (int nt = 0; nt < 4; ++nt) red[((ng * 4 + nt) * 8 + wid) * 64 + lane] = acc[ng][nt];
        __syncthreads();
        if (wid == 0) {
#pragma unroll
            for (int ng = 0; ng < NG; ++ng)
#pragma unroll
                for (int nt = 0; nt < 4; ++nt) { f32x4 t = red[((ng * 4 + nt) * 8) * 64 + lane];
#pragma unroll
                    for (int w = 1; w < 8; ++w) t += red[((ng * 4 + nt) * 8 + w) * 64 + lane];
                    acc[ng][nt] = t; }
            E(task, acc, c16, g); }
        __syncthreads();
    }
}
struct SkSwiGLU { bf16_t* O; const float* ssq;
    __device__ __forceinline__ int brow(int task, int ng) const { const int f0 = 64 * task; return (f0 >> 7) * 256 + (f0 & 127) + ng * 128; }
    __device__ __forceinline__ void operator()(int task, const f32x4 (&acc)[2][4], int c16, int g) const {
#pragma unroll
        for (int r = 0; r < 4; ++r) { const int R = ROW_META + 4 * g + r; const float rs = row_rs(ssq, R);
#pragma unroll
            for (int nt = 0; nt < 4; ++nt) { const float a = acc[0][nt][r] * rs, b = acc[1][nt][r] * rs; O[(size_t)R * FF + 64 * task + 16 * nt + c16] = tobf(a * b * sigmoidf_(a)); } } } };
struct SkResid { bf16_t* HB; float* ssq_out; float alpha;
    __device__ __forceinline__ int brow(int task, int) const { return 64 * task; }
    __device__ __forceinline__ void operator()(int task, const f32x4 (&acc)[1][4], int c16, int g) const {
#pragma unroll
        for (int r = 0; r < 4; ++r) { const int R = ROW_META + 4 * g + r; float s = 0.f;
#pragma unroll
            for (int nt = 0; nt < 4; ++nt) { const size_t off = (size_t)R * DM + 64 * task + 16 * nt + c16; const float o = bf2f(HB[off]) + alpha * acc[0][nt][r]; HB[off] = tobf(o); s += o * o; }
            s += __shfl_xor(s, 1); s += __shfl_xor(s, 2); s += __shfl_xor(s, 4); s += __shfl_xor(s, 8);
            if (c16 == 0) __hip_atomic_fetch_add(ssq_out + R, s, __ATOMIC_RELAXED, __HIP_MEMORY_SCOPE_AGENT); } } };
struct SkHgIn { bf16_t* QB; bf16_t* KB; bf16_t* VB; bf16_t* GB; float* LF; const float* LBv; const float* ssq;
    __device__ __forceinline__ int brow(int task, int) const { return 64 * task; }
    __device__ __forceinline__ void operator()(int task, const f32x4 (&acc)[1][4], int c16, int g) const {
        const int sec = task >> 5;
#pragma unroll
        for (int r = 0; r < 4; ++r) { const int R = ROW_META + 4 * g + r; const float rs = row_rs(ssq, R);
#pragma unroll
            for (int nt = 0; nt < 4; ++nt) { const int col = 64 * (task & 31) + 16 * nt + c16; const size_t off = (size_t)R * DM + col; const float x = acc[0][nt][r] * rs;
                if (sec == 0) QB[off] = tobf(x * sigmoidf_(x));
                else if (sec == 1) { const float lb = LBv[col]; const float fg = lb + (1.0f - lb) * sigmoidf_(x); KB[off] = tobf(1.0f - fg); LF[off] = __logf(fg); }
                else if (sec == 2) VB[off] = tobf(x);
                else GB[off] = tobf(sigmoidf_(x)); } } } };
struct SkFoxIn { bf16_t* QB; bf16_t* KB; bf16_t* VB; bf16_t* GB; float* LFX; const float* bfv; const float* ssq;
    __device__ __forceinline__ int brow(int task, int) const { return 64 * task; }
    __device__ __forceinline__ void operator()(int task, const f32x4 (&acc)[1][4], int c16, int g) const {
        const int sec = task >> 5;
#pragma unroll
        for (int r = 0; r < 4; ++r) { const int R = ROW_META + 4 * g + r; const float rs = row_rs(ssq, R);
            if (sec == 4) { const float z = acc[0][0][r] * rs + bfv[c16]; LFX[(size_t)R * 16 + c16] = fminf(z, 0.f) - __logf(1.0f + fexp(-fabsf(z))); }
            else {
#pragma unroll
                for (int nt = 0; nt < 4; ++nt) { const int col = 64 * (task & 31) + 16 * nt + c16; const size_t off = (size_t)R * DM + col; const float x = acc[0][nt][r] * rs;
                    if (sec == 3) GB[off] = tobf(sigmoidf_(x));
                    else if (sec == 0) QB[off] = tobf(x);
                    else if (sec == 1) KB[off] = tobf(x);
                    else VB[off] = tobf(x); } } } } };
struct SkFgate { float* LFX; const float* bfv; const float* ssq;
    __device__ __forceinline__ int brow(int task, int) const { return 64 * task; }
    __device__ __forceinline__ void operator()(int task, const f32x4 (&acc)[1][4], int c16, int g) const {
        const f32x4 bf = *(const f32x4*)(bfv + 4 * g);
#pragma unroll
        for (int nt = 0; nt < 4; ++nt) { const int R = ROW_X + 64 * task + 16 * nt + c16; const float rs = row_rs(ssq, R); f32x4 o;
#pragma unroll
            for (int r = 0; r < 4; ++r) { const float z = acc[0][nt][r] * rs + bf[r]; o[r] = fminf(z, 0.f) - __logf(1.0f + fexp(-fabsf(z))); }
            *(f32x4*)(LFX + (size_t)R * 16 + 4 * g) = o; } } };
__device__ __forceinline__ void zero_pad_rows(unsigned char* ws, bool hg, int G) {
    const u32x4 z = {0u, 0u, 0u, 0u};
    for (int e = blockIdx.x * NTHREADS + threadIdx.x; e < ROW_META * DM / 8; e += G * NTHREADS) {
        *(u32x4*)(ws + WS_QB + (size_t)e * 16) = z; *(u32x4*)(ws + WS_KB + (size_t)e * 16) = z; *(u32x4*)(ws + WS_VB + (size_t)e * 16) = z; *(u32x4*)(ws + WS_GB + (size_t)e * 16) = z;
        if (hg) { *(u32x4*)(ws + WS_LF + (size_t)e * 32) = z; *(u32x4*)(ws + WS_LF + (size_t)e * 32 + 16) = z; } }
}

#define XB_TMO      128
#define XB_XCNT(j)  (256  + 64 * (j))
#define XB_XSUB(j)  (1280 + 64 * (j))
#define XB_XGEN(j)  (2304 + 64 * (j))
#define XB_TOP      3328
#define XB_TOPGEN   3392
#define XCD_BAR_WORDS 3456
#define XB_SPIN_CAP (1u << 18)
__device__ __forceinline__ unsigned xb_ld(unsigned* p)              { return __hip_atomic_load(p, __ATOMIC_RELAXED, __HIP_MEMORY_SCOPE_AGENT); }
__device__ __forceinline__ unsigned xb_add(unsigned* p, unsigned v) { return __hip_atomic_fetch_add(p, v, __ATOMIC_RELAXED, __HIP_MEMORY_SCOPE_AGENT); }
__device__ __forceinline__ unsigned xb_xcc_id() { return (unsigned)__builtin_amdgcn_s_getreg((3 << 11) | 20) & 0xFu; }
#define XB_SPIN(cond, bar) do { unsigned _sp = 0; while (cond) { __builtin_amdgcn_s_sleep(1); \
    if ((++_sp & 255u) == 0u) { if (xb_ld(&(bar)[XB_TMO])) break; if (_sp > XB_SPIN_CAP) { atomicAdd(&(bar)[XB_TMO], 1u); break; } } } } while (0)
struct XcdBarrier { unsigned* bar; unsigned x; volatile LAS unsigned* st; };
__device__ __forceinline__ XcdBarrier xcd_barrier_post(unsigned* bar, volatile LAS unsigned* st) {
    XcdBarrier b; b.bar = bar; b.x = xb_xcc_id(); b.st = st;
    if (threadIdx.x == 0) (void)xb_add(&bar[XB_XCNT(b.x)], 1u);
    return b;
}
__device__ __forceinline__ void xcd_barrier_complete(unsigned* bar, unsigned x, unsigned& nloc, unsigned& nx) {
    const unsigned G = gridDim.x * gridDim.y * gridDim.z;
    unsigned sum, cnt, mine, sp = 0u;
    for (;;) {
        sum = 0u; cnt = 0u; mine = 0u;
#pragma unroll
        for (unsigned j = 0; j < 16; ++j) { const unsigned c = xb_ld(&bar[XB_XCNT(j)]); sum += c; cnt += (c > 0u) ? 1u : 0u; mine = (j == x) ? c : mine; }
        if (sum == G) break;
        __builtin_amdgcn_s_sleep(1);
        if ((++sp & 255u) == 0u) { if (xb_ld(&bar[XB_TMO])) break; if (sp > XB_SPIN_CAP) { atomicAdd(&bar[XB_TMO], 1u); break; } }
    }
    nloc = mine > 0u ? mine : 1u; nx = cnt > 0u ? cnt : 1u;
}
__device__ __forceinline__ void xcd_barrier(const XcdBarrier& b) {
    asm volatile("s_waitcnt vmcnt(0)" ::: "memory");
    __syncthreads();
    if (threadIdx.x == 0) {
        unsigned* bar = b.bar;
        __builtin_amdgcn_s_waitcnt(0);
        unsigned nloc = b.st[0], nx = b.st[1];
        if (nloc == 0u) { xcd_barrier_complete(bar, b.x, nloc, nx); b.st[0] = nloc; b.st[1] = nx; }
        const unsigned old = xb_add(&bar[XB_XSUB(b.x)], 1u);
        const unsigned gen = old / nloc;
        if (old + 1u == (gen + 1u) * nloc) {
            __builtin_amdgcn_fence(__ATOMIC_RELEASE, "agent");
            asm volatile("s_waitcnt vmcnt(0)" ::: "memory");
            const unsigned og = xb_add(&bar[XB_TOP], 1u);
            const unsigned tg = og / nx;
            if (og + 1u == (tg + 1u) * nx) xb_add(&bar[XB_TOPGEN], 1u);
            else XB_SPIN(xb_ld(&bar[XB_TOPGEN]) == tg, bar);
            __builtin_amdgcn_fence(__ATOMIC_ACQUIRE, "agent");
            xb_add(&bar[XB_XGEN(b.x)], 1u);
            asm volatile("s_waitcnt vmcnt(0)" ::: "memory");
        } else {
            XB_SPIN(xb_ld(&bar[XB_XGEN(b.x)]) == gen, bar);
            __builtin_amdgcn_fence(__ATOMIC_ACQUIRE, "agent");
            asm volatile("s_waitcnt vmcnt(0)" ::: "memory");
        }
    }
    __syncthreads();
}
__device__ __forceinline__ void run_gu(const Args& a, LAS unsigned char* lds, int G, int w, int slot, bool meta) {
    unsigned char* ws = a.ws;
    pg8::Gemm g{(const bf16_t*)(ws + WS_HB) + (size_t)ROW_X * DM, (const bf16_t*)(ws + WS_WGU + w * SZ_WGU1), SEQ, 2 * FF, DM}; pg8::StaticOrder S; S.init(SEQ, 2 * FF, G, (int)blockIdx.x);
    EpiSwiGLU E{(bf16_t*)(ws + WS_ACT), (const float*)(ws + WS_SSQ) + (size_t)slot * TR};
    pg8::gemm_phase<EpiSwiGLU>(lds, g, S, E);
    if (meta) { const int nunit = (SEQ / 256) * (2 * FF / 256), first = (G == 256) ? nunit % G : 0;
        SkSwiGLU K{(bf16_t*)(ws + WS_ACT), (const float*)(ws + WS_SSQ) + (size_t)slot * TR}; skinny_phase<2, SkSwiGLU>(lds, (const bf16_t*)(ws + WS_HB) + (size_t)ROW_META * DM, g.Bt, DM, FF / 64, K, G, first); }
}
__device__ __forceinline__ void run_dn(const Args& a, LAS unsigned char* lds, int G, int w, int slot) {
    unsigned char* ws = a.ws;
    pg8::Gemm g{(const bf16_t*)(ws + WS_ACT) + (size_t)ROW_X * FF, (const bf16_t*)(ws + WS_WDN + w * SZ_WDN1), SEQ, DM, FF}; pg8::StaticOrder S; S.init(SEQ, DM, G, (int)blockIdx.x);
    EpiResid<false> E{(bf16_t*)(ws + WS_HB), (float*)(ws + WS_SSQ) + (size_t)slot * TR, nullptr, 0.5f};
    { SkResid K{(bf16_t*)(ws + WS_HB), (float*)(ws + WS_SSQ) + (size_t)slot * TR, 0.5f}; skinny_phase<1, SkResid>(lds, (const bf16_t*)(ws + WS_ACT) + (size_t)ROW_META * FF, g.Bt, FF, DM / 64, K, G); }
    pg8::gemm_phase<EpiResid<false>>(lds, g, S, E);
}
__device__ __forceinline__ void run_out(const Args& a, LAS unsigned char* lds, int G, size_t woff, int slot, bool meta) {
    unsigned char* ws = a.ws;
    pg8::Gemm g{(const bf16_t*)(ws + WS_OG) + (size_t)ROW_X * DM, (const bf16_t*)(ws + woff), SEQ, DM, DM}; pg8::StaticOrder S; S.init(SEQ, DM, G, (int)blockIdx.x);
    EpiResid<false> E{(bf16_t*)(ws + WS_HB), (float*)(ws + WS_SSQ) + (size_t)slot * TR, nullptr, 1.0f};
    if (meta) { SkResid K{(bf16_t*)(ws + WS_HB), (float*)(ws + WS_SSQ) + (size_t)slot * TR, 1.0f}; skinny_phase<1, SkResid>(lds, (const bf16_t*)(ws + WS_OG) + (size_t)ROW_META * DM, g.Bt, DM, DM / 64, K, G); }
    pg8::gemm_phase<EpiResid<false>>(lds, g, S, E);
}
__global__ void __launch_bounds__(NTHREADS, 2) fwd_megakernel(Args a) {
    extern __shared__ __attribute__((aligned(16))) unsigned char ldsg[];
    LAS unsigned char* lds = (LAS unsigned char*)ldsg;
    cg::grid_group grid = cg::this_grid();
    const int G = gridDim.x;
    unsigned char* ws = a.ws;
#define GRID_SEAM() do { asm volatile("s_waitcnt vmcnt(0) lgkmcnt(0)" ::: "memory"); grid.sync(); \
        if (threadIdx.x < 64) { __builtin_amdgcn_fence(__ATOMIC_ACQUIRE, "agent"); asm volatile("s_waitcnt vmcnt(0)" ::: "memory"); } \
        __syncthreads(); asm volatile("" ::: "memory"); } while (0)
    volatile LAS unsigned* xst = (volatile LAS unsigned*)(lds + LDS_XST);
    if (threadIdx.x < 2) xst[threadIdx.x] = 0u;
    __syncthreads();
    const XcdBarrier xbar = xcd_barrier_post((unsigned*)(ws + WS_CTL), xst);
#define RUN(k, ...) if (EN(k) && a.ph_lo <= (k) && (k) < a.ph_hi) { __VA_ARGS__; if ((k) + 1 < a.ph_hi) { if ((k) == PH_PREP) GRID_SEAM(); else { xcd_barrier(xbar); asm volatile("" ::: "memory"); } } }
    RUN(PH_PREP, phase_prep(a, lds, G))
    RUN(PH_L0_F1, run_gu(a, lds, G, 0, 0, true))
    RUN(PH_L0_F2, run_dn(a, lds, G, 0, 1))
    RUN(PH_HG_IN, {
        pg8::Gemm g{(const bf16_t*)(ws + WS_HB) + (size_t)ROW_X * DM, (const bf16_t*)(ws + WS_WHI), SEQ, HG_N, DM}; pg8::StaticOrder S; S.init(SEQ, HG_N, G, (int)blockIdx.x);
        EpiHgIn E{(bf16_t*)(ws + WS_QB), (bf16_t*)(ws + WS_KB), (bf16_t*)(ws + WS_VB), (bf16_t*)(ws + WS_GB), (float*)(ws + WS_LF), (const float*)(ws + WS_LB), (const float*)(ws + WS_SSQ) + (size_t)1 * TR};
        zero_pad_rows(ws, true, G);
        { SkHgIn K{E.QB, E.KB, E.VB, E.GB, E.LF, E.LBv, E.ssq}; skinny_phase<1, SkHgIn>(lds, (const bf16_t*)(ws + WS_HB) + (size_t)ROW_META * DM, g.Bt, DM, HG_N / 64, K, G); }
        pg8::gemm_phase<EpiHgIn>(lds, g, S, E); })
    RUN(PH_H1, phase_h1(a, lds, G))
    RUN(PH_H2, phase_h2(a, G))
    RUN(PH_H3, phase_h3(a, lds, G))
    RUN(PH_HG_OUT, run_out(a, lds, G, WS_WHO, 2, true))
    RUN(PH_L0_F3, run_gu(a, lds, G, 1, 2, true))
    RUN(PH_L0_F4, run_dn(a, lds, G, 1, 3))
    RUN(PH_L1_F1, run_gu(a, lds, G, 2, 3, true))
    RUN(PH_L1_F2, run_dn(a, lds, G, 2, 4))
    RUN(PH_FX_IN, {
        pg8::Gemm g{(const bf16_t*)(ws + WS_HB) + (size_t)ROW_X * DM, (const bf16_t*)(ws + WS_WFI), SEQ, 8192, DM}; pg8::StaticOrder S; S.init(SEQ, 8192, G, (int)blockIdx.x);
        EpiFoxIn E{(bf16_t*)(ws + WS_QB), (bf16_t*)(ws + WS_KB), (bf16_t*)(ws + WS_VB), (bf16_t*)(ws + WS_GB), (float*)(ws + WS_LFX), a.fox_b_f, (const float*)(ws + WS_SSQ) + (size_t)4 * TR};
        zero_pad_rows(ws, false, G);
        { SkFoxIn K{E.QB, E.KB, E.VB, E.GB, E.LFX, E.bfv, E.ssq}; skinny_phase<1, SkFoxIn>(lds, (const bf16_t*)(ws + WS_HB) + (size_t)ROW_META * DM, g.Bt, DM, 8192 / 64 + 1, K, G); }
        { SkFgate K{E.LFX, E.bfv, E.ssq}; skinny_phase<1, SkFgate>(lds, (const bf16_t*)(ws + WS_WFI) + (size_t)8192 * DM, (const bf16_t*)(ws + WS_HB) + (size_t)ROW_X * DM, DM, SEQ / 64, K, G); }
        pg8::gemm_phase<EpiFoxIn>(lds, g, S, E); })
    RUN(PH_X2, phase_x2(a, G))
    RUN(PH_X3, phase_x3(a, ldsg, G))
    RUN(PH_FX_OUT, run_out(a, lds, G, WS_WFO, 5, false))
    RUN(PH_L1_F3, run_gu(a, lds, G, 3, 5, false))
    RUN(PH_L1_F4, {
        pg8::Gemm g{(const bf16_t*)(ws + WS_ACT) + (size_t)ROW_X * FF, (const bf16_t*)(ws + WS_WDN + 3 * SZ_WDN1), SEQ, DM, FF}; pg8::StaticOrder S; S.init(SEQ, DM, G, (int)blockIdx.x);
        EpiResid<true> E{(bf16_t*)(ws + WS_HB), nullptr, a.out, 0.5f};
        pg8::gemm_phase<EpiResid<true>>(lds, g, S, E); })
#undef RUN
}

#ifndef N_LAUNCH_SPLIT
#define N_LAUNCH_SPLIT 0
#endif
extern "C" void kernel_launch(void* const* d_in, const int* in_sizes, int n_in, void* d_out, int out_size, void* d_ws, size_t ws_size, hipStream_t stream) {
    static int grid = 0;
    if (grid == 0) {
        if (n_in != 14 || ws_size < WS_END) { fprintf(stderr, "kernel_launch: unexpected inputs (n_in %d, ws %zu < %zu)\n", n_in, ws_size, (size_t)WS_END); grid = -1; return; }
        int dev = 0, cus = 0, per_cu = 0;
        (void)hipGetDevice(&dev); (void)hipDeviceGetAttribute(&cus, hipDeviceAttributeMultiprocessorCount, dev);
        if (hipFuncSetAttribute((const void*)fwd_megakernel, hipFuncAttributeMaxDynamicSharedMemorySize, LDS_BYTES) != hipSuccess) { fprintf(stderr, "kernel_launch: hipFuncSetAttribute failed\n"); grid = -1; return; }
        if (hipOccupancyMaxActiveBlocksPerMultiprocessor(&per_cu, (const void*)fwd_megakernel, NTHREADS, LDS_BYTES) != hipSuccess || per_cu < 1) { fprintf(stderr, "kernel_launch: occupancy query says %d\n", per_cu); per_cu = 1; }
        (void)hipGetLastError();
        grid = cus > 0 ? cus : 256;
    }
    if (grid < 0) return;
    (void)hipMemsetAsync((char*)d_ws + WS_CTL, 0, 16384, stream);
    Args a{};
    a.x = (const float*)d_in[0]; a.meta = (const float*)d_in[1]; a.norm_g = (const float*)d_in[2]; a.w_gu = (const float*)d_in[3]; a.w_dn = (const float*)d_in[4];
    a.lb_logits = (const float*)d_in[5]; a.hg_w_in = (const float*)d_in[6]; a.hg_w_out = (const float*)d_in[7]; a.hg_onorm = (const float*)d_in[8]; a.fox_w_in = (const float*)d_in[9];
    a.fox_b_f = (const float*)d_in[10]; a.fox_w_out = (const float*)d_in[11]; a.fox_qnorm = (const float*)d_in[12]; a.fox_knorm = (const float*)d_in[13];
    a.out = (float*)d_out; a.ws = (unsigned char*)d_ws;
#if N_LAUNCH_SPLIT
    for (int ph = 0; ph < NPH; ++ph) { a.ph_lo = ph; a.ph_hi = ph + 1; void* args[] = {&a};
        hipError_t e = hipLaunchCooperativeKernel((const void*)fwd_megakernel, dim3(grid), dim3(NTHREADS), args, LDS_BYTES, stream);
        if (e != hipSuccess) { fprintf(stderr, "cooperative launch failed: %s\n", hipGetErrorString(e)); break; } }
#else
    a.ph_lo = 0; a.ph_hi = NPH; void* args[] = {&a};
    hipError_t e = hipLaunchCooperativeKernel((const void*)fwd_megakernel, dim3(grid), dim3(NTHREADS), args, LDS_BYTES, stream);
    if (e != hipSuccess) fprintf(stderr, "cooperative launch failed: %s (grid %d)\n", hipGetErrorString(e), grid);
#endif
}
```

```cpp
#include <hip/hip_runtime.h>
#include <hip/hip_cooperative_groups.h>
#include <cstdio>
#include <cstdint>
namespace cg = cooperative_groups;

#define LAS __attribute__((address_space(3)))
typedef unsigned short bf16_t;
typedef short bf16x8 __attribute__((ext_vector_type(8)));
typedef short s16x4 __attribute__((ext_vector_type(4)));
typedef float f32x4 __attribute__((ext_vector_type(4)));
typedef float f32x2 __attribute__((ext_vector_type(2)));
typedef float f32x16 __attribute__((ext_vector_type(16)));
typedef unsigned u32x4 __attribute__((ext_vector_type(4)));
typedef unsigned u32x2 __attribute__((ext_vector_type(2)));

constexpr int DM = 2048, SEQ = 16384, NMETA = 16, FF = 5504, NH = 16, HD = 128;
constexpr int TR = 16640;
constexpr int ROW_META = 240, ROW_X = 256;
constexpr int NCHUNK = TR / 128;
constexpr int HG_N = 8192, FX_N = 8448  , FX_NREAL = 8208;
constexpr float RMS_EPS = 1e-6f;
constexpr int NTHREADS = 512, NWAVES = 8;

constexpr size_t al256(size_t x) { return (x + 255) & ~(size_t)255; }
constexpr size_t WS_CTL = 0;
constexpr size_t WS_WGU = 16384;
constexpr size_t SZ_WGU1 = (size_t)2 * FF * DM * 2;
constexpr size_t WS_WDN = WS_WGU + 4 * SZ_WGU1;
constexpr size_t SZ_WDN1 = (size_t)DM * FF * 2;
constexpr size_t WS_WHI = WS_WDN + 4 * SZ_WDN1;
constexpr size_t WS_WHO = WS_WHI + (size_t)HG_N * DM * 2;
constexpr size_t WS_WFI = WS_WHO + (size_t)DM * DM * 2;
constexpr size_t WS_WFO = WS_WFI + (size_t)FX_N * DM * 2;
constexpr size_t WS_H = WS_WFO + (size_t)DM * DM * 2;
constexpr size_t WS_HB = WS_H + (size_t)TR * DM * 4;
constexpr size_t WS_SSQ = WS_HB + (size_t)TR * DM * 2;
constexpr size_t WS_LB = WS_SSQ + al256((size_t)6 * TR * 4);
constexpr size_t WS_U0 = WS_LB + 8192;
constexpr size_t WS_ACT = WS_U0;
constexpr size_t SZ_TB = (size_t)TR * DM * 2;
constexpr size_t WS_QB = WS_U0, WS_KB = WS_QB + SZ_TB, WS_VB = WS_KB + SZ_TB, WS_GB = WS_VB + SZ_TB, WS_OG = WS_GB + SZ_TB;
constexpr size_t WS_LF = WS_OG + SZ_TB;
constexpr size_t WS_UT = WS_LF + (size_t)TR * DM * 4;
constexpr size_t WS_ST = WS_UT + (size_t)NCHUNK * NH * HD * HD * 4;
constexpr size_t WS_DEC = WS_ST + (size_t)NCHUNK * NH * HD * HD * 2;
constexpr size_t WS_LFX = WS_DEC + al256((size_t)NCHUNK * NH * HD * 4);
constexpr size_t WS_LOC = WS_LFX + (size_t)TR * 16 * 4;
constexpr size_t WS_SEG = WS_LOC + (size_t)TR * 16 * 4;
constexpr size_t WS_RK = WS_SEG + al256((size_t)NCHUNK * 16 * 4);
constexpr size_t WS_END = WS_RK + (size_t)TR * 16 * 4;
static_assert(WS_ACT + (size_t)TR * FF * 2 <= WS_END, "act fits in union");
static_assert(WS_END <= (size_t)4 * 2 * 2 * DM * 2 * FF * 4, "workspace exceeds the guaranteed 4x largest tensor");

constexpr int LDS_BYTES = 147456 + 1024;
constexpr int LDS_XST = 147456;
constexpr int NDEFER_DN = 256;

typedef __bf16 bf16x2_t __attribute__((ext_vector_type(2)));
__device__ __forceinline__ unsigned cvtpk(float lo, float hi) { bf16x2_t v = {(__bf16)lo, (__bf16)hi}; return __builtin_bit_cast(unsigned, v); }
__device__ __forceinline__ float bf2f(unsigned short b) { return __uint_as_float(((unsigned)b) << 16); }
__device__ __forceinline__ float bflo(unsigned w) { return __uint_as_float(w << 16); }
__device__ __forceinline__ float bfhi(unsigned w) { return __uint_as_float(w & 0xffff0000u); }
__device__ __forceinline__ bf16x8 pack8(f32x4 a, f32x4 b) { u32x4 w = {cvtpk(a[0], a[1]), cvtpk(a[2], a[3]), cvtpk(b[0], b[1]), cvtpk(b[2], b[3])}; return *reinterpret_cast<bf16x8*>(&w); }
__device__ __forceinline__ float fexp(float x) { return __builtin_amdgcn_exp2f(x * 1.4426950408889634f); }
__device__ __forceinline__ float sigmoidf_(float x) { return __builtin_amdgcn_rcpf(1.0f + fexp(-x)); }
__device__ __forceinline__ float wave_sum(float v) {
#pragma unroll
    for (int o = 1; o < 64; o <<= 1) v += __shfl_xor(v, o);
    return v;
}

namespace pg8 {
constexpr int BM = 256, BK = 64, HALF = 128, HTB = HALF * BK * 2, STAGE_BYTES = 8 * HTB, NXCD = 8, WGM = 8;
__host__ __device__ __forceinline__ int lds_byte(int r, int c) { const int st = (r >> 4) * 2 + (c >> 5), rr = r & 15, cc = c & 31, ob = rr * 64 + cc * 2; return st * 1024 + (ob ^ (((ob >> 9) & 1) << 5)); }
__host__ __device__ __forceinline__ void stage_rc(int b, int& R, int& C) { const int st = b / 1024, sb = b % 1024, swz = sb ^ (((sb >> 9) & 1) << 5); R = (st >> 1) * 16 + swz / 64; C = (st & 1) * 32 + (swz % 64) / 2; }
__host__ __device__ __forceinline__ int perm32(int rho) { const int n = rho >> 4, i = rho & 15; return 8 * (i >> 2) + 4 * n + (i & 3); }
struct Unit { int pm, pn; };
struct Gemm { const bf16_t* A; const bf16_t* Bt; int M, N, K; };
struct StaticOrder {
    int nM, nN, nwg, G, c;
    __device__ void init(int M, int N, int G_, int c_) { nM = M / BM; nN = N / BM; nwg = nM * nN; G = G_; c = c_; }
    __device__ bool next(int i, Unit& u) const {
        const long L = (long)i * G + c; if (L >= nwg) return false;
        int wgid = (int)L; { const int q = nwg / NXCD, r = nwg % NXCD, xcd = wgid % NXCD, off = wgid / NXCD; wgid = (xcd < r ? xcd * (q + 1) : r * (q + 1) + (xcd - r) * q) + off; }
        const int nig = WGM * nN, gid = wgid / nig, fm = gid * WGM, gsz = (nM - fm) < WGM ? (nM - fm) : WGM;
        u.pm = fm + ((wgid % nig) % gsz); u.pn = (wgid % nig) / gsz; return true;
    }
};

template <class Epi>
__device__ __forceinline__ void gemm_phase(LAS unsigned char* lds, const Gemm g, const StaticOrder& S, const Epi& E) {
    const int tid = threadIdx.x, wid = __builtin_amdgcn_readfirstlane(tid >> 6), lane = tid & 63, wr = wid >> 2, wc = wid & 3, fr = lane & 15, fq = lane >> 4;
    const int K = g.K, nt = K / BK;
    unsigned voffA[2], voffB[2];
#pragma unroll
    for (int i = 0; i < 2; ++i) { int R, C; stage_rc(tid * 16 + i * 8192, R, C); const int Rb = Epi::PERM ? ((R & ~31) + perm32(R & 31)) : R;
        voffA[i] = (unsigned)(R * K + C) * 2u; voffB[i] = (unsigned)(Rb * K + C) * 2u; }
    const size_t kstep = (size_t)(BK * 2);
    const size_t hstep = (size_t)HALF * K * 2;
    const size_t tstep = 2 * hstep;
    const unsigned ldsw = (unsigned)wid * 1024u;
    const int aoff = lds_byte(wr * 64 + fr, fq * 8), boff = lds_byte(wc * 32 + fr, fq * 8);
#define PG8_SA(b, h) (((b) * 2 + (h)) * HTB)
#define PG8_SB(b, h) ((4 + (b) * 2 + (h)) * HTB)
#define PG8_STAGE(bufoff, gbase, voff) do { _Pragma("unroll") for (int _i = 0; _i < 2; ++_i) \
        __builtin_amdgcn_global_load_lds((const unsigned*)((const char*)(gbase) + (voff)[_i]), (LAS unsigned*)(lds + (bufoff) + ldsw + _i * 8192), 16, 0, 0); } while (0)
#define PG8_LDA(dst, b, h) do { _Pragma("unroll") for (int m = 0; m < 4; ++m) _Pragma("unroll") for (int k = 0; k < 2; ++k) dst[m][k] = *(const LAS bf16x8*)(lds + PG8_SA(b, h) + aoff + m * 2048 + k * 1024); } while (0)
#define PG8_LDB(dst, b, h) do { _Pragma("unroll") for (int n = 0; n < 2; ++n) _Pragma("unroll") for (int k = 0; k < 2; ++k) dst[n][k] = *(const LAS bf16x8*)(lds + PG8_SB(b, h) + boff + n * 2048 + k * 1024); } while (0)
#define PG8_MMA(ai, bj, At, Bt) do { __builtin_amdgcn_s_setprio(1); _Pragma("unroll") for (int m = 0; m < 4; ++m) _Pragma("unroll") for (int n = 0; n < 2; ++n) _Pragma("unroll") for (int k = 0; k < 2; ++k) \
        acc[ai][bj][m][n] = __builtin_amdgcn_mfma_f32_16x16x32_bf16(Bt[n][k], At[m][k], acc[ai][bj][m][n], 0, 0, 0); __builtin_amdgcn_s_setprio(0); } while (0)
#define PG8_WAIT_V(n) asm volatile("s_waitcnt vmcnt(" #n ")" ::: "memory")
#define PG8_WAIT_L(n) asm volatile("s_waitcnt lgkmcnt(" #n ")" ::: "memory")
#define PG8_BAR __builtin_amdgcn_s_barrier()
#define PG8_SCHED __builtin_amdgcn_sched_barrier(0)
    Unit cur, nxt; int ui = 0;
    if (!S.next(0, cur)) return;
    f32x4 acc[2][2][4][2];
#pragma unroll
    for (int a = 0; a < 2; ++a)
#pragma unroll
        for (int b = 0; b < 2; ++b)
#pragma unroll
            for (int m = 0; m < 4; ++m)
#pragma unroll
                for (int n = 0; n < 2; ++n) acc[a][b][m][n] = (f32x4){0.f, 0.f, 0.f, 0.f};
    bf16x8 At[4][2], B0[2][2], B1[2][2];
    const char* cA = (const char*)g.A + (size_t)cur.pm * tstep; const char* cB = (const char*)g.Bt + (size_t)cur.pn * tstep;
    typename Epi::Pre pre = E.pre(cur, wr, fr);
    PG8_STAGE(PG8_SB(0, 0), cB, voffB); PG8_STAGE(PG8_SA(0, 0), cA, voffA); PG8_STAGE(PG8_SB(0, 1), cB + hstep, voffB); PG8_STAGE(PG8_SA(0, 1), cA + hstep, voffA);
    if (wr == 1) PG8_BAR;
    PG8_WAIT_V(4); PG8_BAR;
    PG8_STAGE(PG8_SB(1, 0), cB + kstep, voffB); PG8_STAGE(PG8_SA(1, 0), cA + kstep, voffA); PG8_STAGE(PG8_SB(1, 1), cB + hstep + kstep, voffB);
    PG8_WAIT_V(6); PG8_BAR;
    for (;;) {
        const bool has_next = S.next(ui + 1, nxt);
        const char* nA = has_next ? (const char*)g.A + (size_t)nxt.pm * tstep : cA; const char* nB = has_next ? (const char*)g.Bt + (size_t)nxt.pn * tstep : cB;
        for (int t = 0; t < nt; t += 2) {
            const bool last = (t == nt - 2);
            const char* a1 = cA + (size_t)(t + 1) * kstep;
            const char* a2 = last ? nA : cA + (size_t)(t + 2) * kstep; const char* b2 = last ? nB : cB + (size_t)(t + 2) * kstep;
            const char* a3 = a2 + kstep; const char* b3 = b2 + kstep;
            PG8_LDB(B0, 0, 0); PG8_SCHED; PG8_LDA(At, 0, 0); PG8_STAGE(PG8_SA(1, 1), a1 + hstep, voffA);
            PG8_WAIT_L(8); PG8_BAR; PG8_WAIT_L(0); PG8_MMA(0, 0, At, B0); PG8_BAR; PG8_SCHED;
            PG8_LDB(B1, 0, 1); PG8_STAGE(PG8_SB(0, 0), b2, voffB);
            PG8_BAR; PG8_WAIT_L(0); PG8_MMA(0, 1, At, B1); PG8_BAR;
            PG8_LDA(At, 0, 1); PG8_STAGE(PG8_SA(0, 0), a2, voffA);
            PG8_BAR; PG8_WAIT_L(0); PG8_MMA(1, 0, At, B0); PG8_BAR; PG8_SCHED;
            PG8_STAGE(PG8_SB(0, 1), b2 + hstep, voffB);
            PG8_WAIT_V(6); PG8_BAR; PG8_MMA(1, 1, At, B1); PG8_BAR;
            PG8_LDB(B0, 1, 0); PG8_SCHED; PG8_LDA(At, 1, 0); PG8_STAGE(PG8_SA(0, 1), a2 + hstep, voffA);
            PG8_WAIT_L(8); PG8_BAR; PG8_WAIT_L(0); PG8_MMA(0, 0, At, B0); PG8_BAR; PG8_SCHED;
            PG8_LDB(B1, 1, 1); PG8_STAGE(PG8_SB(1, 0), b3, voffB);
            PG8_BAR; PG8_WAIT_L(0); PG8_MMA(0, 1, At, B1); PG8_BAR;
            PG8_LDA(At, 1, 1); PG8_STAGE(PG8_SA(1, 0), a3, voffA);
            PG8_BAR; PG8_WAIT_L(0); PG8_MMA(1, 0, At, B0); PG8_BAR; PG8_SCHED;
            PG8_STAGE(PG8_SB(1, 1), b3 + hstep, voffB);
            PG8_WAIT_V(6); PG8_BAR; PG8_MMA(1, 1, At, B1); PG8_BAR;
        }
        E(acc, cur, wr, wc, fr, fq, pre);
        if (!has_next) break;
        pre = E.pre(nxt, wr, fr);
#pragma unroll
        for (int a = 0; a < 2; ++a)
#pragma unroll
            for (int b = 0; b < 2; ++b)
#pragma unroll
                for (int m = 0; m < 4; ++m)
#pragma unroll
                    for (int n = 0; n < 2; ++n) acc[a][b][m][n] = (f32x4){0.f, 0.f, 0.f, 0.f};
        cur = nxt; cA = nA; cB = nB; ++ui;
    }
    PG8_WAIT_V(0);
    if (wr == 0) PG8_BAR;
    PG8_BAR;
#undef PG8_SA
#undef PG8_SB
#undef PG8_STAGE
#undef PG8_LDA
#undef PG8_LDB
#undef PG8_MMA
#undef PG8_WAIT_V
#undef PG8_WAIT_L
#undef PG8_BAR
#undef PG8_SCHED
}
}
using pg8::Unit; using pg8::HALF; using pg8::BM;

__device__ __forceinline__ float row_rs(const float* ssq, int r) { return __builtin_amdgcn_rsqf(ssq[r] * (1.0f / DM) + RMS_EPS); }

struct PreRs { float rs[8]; };
__device__ __forceinline__ PreRs load_rs(const float* ssq, int pm, int wr, int fr) { PreRs p;
#pragma unroll
    for (int ai = 0; ai < 2; ++ai)
#pragma unroll
        for (int m = 0; m < 4; ++m) p.rs[ai * 4 + m] = ssq[ROW_X + pm * BM + ai * HALF + wr * 64 + m * 16 + fr];
    return p; }
struct PreNone {};
struct EpiSwiGLU {
    static constexpr bool PERM = true;
    bf16_t* O; const float* ssq; typedef PreRs Pre;
    __device__ __forceinline__ Pre pre(const Unit& u, int wr, int fr) const { return load_rs(ssq, u.pm, wr, fr); }
    __device__ __forceinline__ void operator()(const f32x4 (&acc)[2][2][4][2], const Unit& u, int wr, int wc, int fr, int fq, const Pre& P) const {
        const int row0 = ROW_X + u.pm * BM + wr * 64 + fr, col0 = u.pn * HALF + wc * 32 + 8 * fq;
#pragma unroll
        for (int ai = 0; ai < 2; ++ai)
#pragma unroll
            for (int m = 0; m < 4; ++m) { const int r = row0 + ai * HALF + m * 16; const float rs = __builtin_amdgcn_rsqf(P.rs[ai * 4 + m] * (1.0f / DM) + RMS_EPS);
                float y[8];
#pragma unroll
                for (int n = 0; n < 2; ++n)
#pragma unroll
                    for (int j = 0; j < 4; ++j) { const float a = acc[ai][0][m][n][j] * rs, b = acc[ai][1][m][n][j] * rs; y[n * 4 + j] = a * b * sigmoidf_(a); }
                u32x4 w; w.x = cvtpk(y[0], y[1]); w.y = cvtpk(y[2], y[3]); w.z = cvtpk(y[4], y[5]); w.w = cvtpk(y[6], y[7]);
                *(u32x4*)(O + (size_t)r * FF + col0) = w; }
    }
};
template <bool FINAL> struct EpiResid {
    static constexpr bool PERM = true;
    bf16_t* HB; float* ssq_out; float* OUT; float alpha; typedef PreNone Pre;
    __device__ __forceinline__ Pre pre(const Unit&, int, int) const { return Pre{}; }
    __device__ __forceinline__ void operator()(const f32x4 (&acc)[2][2][4][2], const Unit& u, int wr, int wc, int fr, int fq, const Pre&) const {
        const int row0 = ROW_X + u.pm * BM + wr * 64 + fr, col0 = u.pn * BM + wc * 32 + 8 * fq;
        u32x4 hv[2][2]; float sprev = 0.f;
#define ER_LOAD(g_, set_) do { const size_t off_ = (size_t)(row0 + ((g_) >> 2) * HALF + ((g_) & 3) * 16) * DM + col0; \
        hv[set_][0] = *(const u32x4*)(HB + off_); hv[set_][1] = *(const u32x4*)(HB + off_ + HALF); } while (0)
        ER_LOAD(0, 0);
#pragma unroll
        for (int g = 0; g < 8; ++g) { const int ai = g >> 2, m = g & 3; const int r = row0 + ai * HALF + m * 16; const size_t off = (size_t)r * DM + col0; float s = 0.f;
            if (g + 1 < 8) ER_LOAD(g + 1, (g + 1) & 1);
#pragma unroll
            for (int bj = 0; bj < 2; ++bj) { const u32x4 w = hv[g & 1][bj];
                const f32x4 h0 = {bflo(w.x), bfhi(w.x), bflo(w.y), bfhi(w.y)}, h1 = {bflo(w.z), bfhi(w.z), bflo(w.w), bfhi(w.w)};
                const f32x4 o0 = h0 + acc[ai][bj][m][0] * alpha, o1 = h1 + acc[ai][bj][m][1] * alpha;
                if (FINAL) { float* op = OUT + (size_t)(r - ROW_X) * DM + col0 + bj * HALF; *(f32x4*)op = o0; *(f32x4*)(op + 4) = o1; }
                else { u32x4 q; q.x = cvtpk(o0[0], o0[1]); q.y = cvtpk(o0[2], o0[3]); q.z = cvtpk(o1[0], o1[1]); q.w = cvtpk(o1[2], o1[3]); *(u32x4*)(HB + off + bj * HALF) = q;
                       s += ((o0[0] * o0[0] + o0[1] * o0[1]) + (o0[2] * o0[2] + o0[3] * o0[3])) + ((o1[0] * o1[0] + o1[1] * o1[1]) + (o1[2] * o1[2] + o1[3] * o1[3])); } }
            if (!FINAL) { if (g > 0) { float t = sprev; t += __shfl_xor(t, 16); t += __shfl_xor(t, 32);
                    if (fq == 0) __hip_atomic_fetch_add(ssq_out + row0 + ((g - 1) >> 2) * HALF + ((g - 1) & 3) * 16, t, __ATOMIC_RELAXED, __HIP_MEMORY_SCOPE_AGENT); }
                sprev = s; } }
#undef ER_LOAD
        if (!FINAL) { float t = sprev; t += __shfl_xor(t, 16); t += __shfl_xor(t, 32);
            if (fq == 0) __hip_atomic_fetch_add(ssq_out + row0 + HALF + 48, t, __ATOMIC_RELAXED, __HIP_MEMORY_SCOPE_AGENT); }
    }
};
struct EpiHgIn {
    static constexpr bool PERM = true;
    bf16_t* QB; bf16_t* KB; bf16_t* VB; bf16_t* GB; float* LF; const float* LBv; const float* ssq; typedef PreRs Pre;
    __device__ __forceinline__ Pre pre(const Unit& u, int wr, int fr) const { return load_rs(ssq, u.pm, wr, fr); }
    __device__ __forceinline__ void operator()(const f32x4 (&acc)[2][2][4][2], const Unit& u, int wr, int wc, int fr, int fq, const Pre& P) const {
        const int sec = u.pn >> 3, row0 = ROW_X + u.pm * BM + wr * 64 + fr, colb = (u.pn & 7) * BM + wc * 32 + 8 * fq;
#pragma unroll
        for (int ai = 0; ai < 2; ++ai)
#pragma unroll
            for (int m = 0; m < 4; ++m) { const int r = row0 + ai * HALF + m * 16; const float rs = __builtin_amdgcn_rsqf(P.rs[ai * 4 + m] * (1.0f / DM) + RMS_EPS);
#pragma unroll
                for (int bj = 0; bj < 2; ++bj) { const int c = colb + bj * HALF; const size_t off = (size_t)r * DM + c; float x[8], y[8];
#pragma unroll
                    for (int n = 0; n < 2; ++n)
#pragma unroll
                        for (int j = 0; j < 4; ++j) x[n * 4 + j] = acc[ai][bj][m][n][j] * rs;
                    bf16_t* dst;
                    if (sec == 0) { dst = QB;
#pragma unroll
                        for (int j = 0; j < 8; ++j) y[j] = x[j] * sigmoidf_(x[j]); }
                    else if (sec == 1) { dst = KB; const f32x4 l0 = *(const f32x4*)(LBv + c), l1 = *(const f32x4*)(LBv + c + 4); float lf[8];
#pragma unroll
                        for (int j = 0; j < 8; ++j) { const float lb = j < 4 ? l0[j] : l1[j - 4]; const float fg = lb + (1.0f - lb) * sigmoidf_(x[j]); y[j] = 1.0f - fg; lf[j] = __logf(fg); }
                        *(f32x4*)(LF + off) = (f32x4){lf[0], lf[1], lf[2], lf[3]}; *(f32x4*)(LF + off + 4) = (f32x4){lf[4], lf[5], lf[6], lf[7]}; }
                    else if (sec == 2) { dst = VB;
#pragma unroll
                        for (int j = 0; j < 8; ++j) y[j] = x[j]; }
                    else { dst = GB;
#pragma unroll
                        for (int j = 0; j < 8; ++j) y[j] = sigmoidf_(x[j]); }
                    u32x4 w; w.x = cvtpk(y[0], y[1]); w.y = cvtpk(y[2], y[3]); w.z = cvtpk(y[4], y[5]); w.w = cvtpk(y[6], y[7]);
                    *(u32x4*)(dst + off) = w; } }
    }
};
struct EpiFoxIn {
    static constexpr bool PERM = true;
    bf16_t* QB; bf16_t* KB; bf16_t* VB; bf16_t* GB; float* LFX; const float* bfv; const float* ssq; typedef PreRs Pre;
    __device__ __forceinline__ Pre pre(const Unit& u, int wr, int fr) const { return load_rs(ssq, u.pm, wr, fr); }
    __device__ __forceinline__ void operator()(const f32x4 (&acc)[2][2][4][2], const Unit& u, int wr, int wc, int fr, int fq, const Pre& P) const {
        const int sec = u.pn >> 3, row0 = ROW_X + u.pm * BM + wr * 64 + fr, colb = (u.pn & 7) * BM + wc * 32 + 8 * fq;
#pragma unroll
        for (int ai = 0; ai < 2; ++ai)
#pragma unroll
            for (int m = 0; m < 4; ++m) { const int r = row0 + ai * HALF + m * 16; const float rs = __builtin_amdgcn_rsqf(P.rs[ai * 4 + m] * (1.0f / DM) + RMS_EPS);
                if (sec == 4) {
                    if (wc == 0 && fq < 2) {
#pragma unroll
                        for (int n = 0; n < 2; ++n) { f32x4 o;
#pragma unroll
                            for (int j = 0; j < 4; ++j) { const float z = acc[ai][0][m][n][j] * rs + bfv[8 * fq + 4 * n + j]; o[j] = fminf(z, 0.f) - __logf(1.0f + fexp(-fabsf(z))); }
                            *(f32x4*)(LFX + (size_t)r * 16 + 8 * fq + 4 * n) = o; } }
                } else {
#pragma unroll
                    for (int bj = 0; bj < 2; ++bj) { const size_t off = (size_t)r * DM + colb + bj * HALF; float y[8];
#pragma unroll
                        for (int n = 0; n < 2; ++n)
#pragma unroll
                            for (int j = 0; j < 4; ++j) { const float x = acc[ai][bj][m][n][j] * rs; y[n * 4 + j] = (sec == 3) ? sigmoidf_(x) : x; }
                        bf16_t* dst = sec == 0 ? QB : sec == 1 ? KB : sec == 2 ? VB : GB;
                        u32x4 w; w.x = cvtpk(y[0], y[1]); w.y = cvtpk(y[2], y[3]); w.z = cvtpk(y[4], y[5]); w.w = cvtpk(y[6], y[7]);
                        *(u32x4*)(dst + off) = w; } } }
    }
};

struct Args {
    const float* x; const float* meta; const float* norm_g; const float* w_gu; const float* w_dn; const float* lb_logits; const float* hg_w_in; const float* hg_w_out;
    const float* hg_onorm; const float* fox_w_in; const float* fox_b_f; const float* fox_w_out; const float* fox_qnorm; const float* fox_knorm;
    float* out; unsigned char* ws; int ph_lo, ph_hi;
};
#ifndef PHMASK
#define PHMASK 0xFFFFFFFFu
#endif
#define EN(p) (((PHMASK) >> (p)) & 1u)
enum { PH_PREP = 0, PH_L0_F1, PH_L0_F2, PH_HG_IN, PH_H1, PH_H2, PH_H3, PH_HG_OUT, PH_L0_F3, PH_L0_F4, PH_L1_F1, PH_L1_F2, PH_FX_IN, PH_X2, PH_X3, PH_FX_OUT, PH_L1_F3, PH_L1_F4, NPH };

__device__ __forceinline__ void transpose_tile64(const float* W, int K, int ldn, bf16_t* WT, const float* gain, int k0, int n0, int drow0, LAS float* scr, int lane) {
    f32x2 v[32];
#pragma unroll
    for (int i = 0; i < 32; ++i) { const int kk = 2 * i + (lane >> 5); v[i] = *(const f32x2*)(W + (size_t)(k0 + kk) * ldn + n0 + 2 * (lane & 31)); }
#pragma unroll
    for (int i = 0; i < 32; ++i) { const int kk = 2 * i + (lane >> 5); const float gs = gain ? gain[k0 + kk] : 1.0f; scr[kk * 65 + 2 * (lane & 31)] = v[i][0] * gs; scr[kk * 65 + 2 * (lane & 31) + 1] = v[i][1] * gs; }
    asm volatile("s_waitcnt lgkmcnt(0)" ::: "memory");
    const int c = lane & 7;
#pragma unroll
    for (int j = 0; j < 8; ++j) { const int n = (lane >> 3) + 8 * j; const LAS float* p = scr + (8 * c) * 65 + n;
        u32x4 o; o.x = cvtpk(p[0 * 65], p[1 * 65]); o.y = cvtpk(p[2 * 65], p[3 * 65]); o.z = cvtpk(p[4 * 65], p[5 * 65]); o.w = cvtpk(p[6 * 65], p[7 * 65]);
        *(u32x4*)(WT + (size_t)(drow0 + n) * K + k0 + 8 * c) = o; }
    asm volatile("s_waitcnt lgkmcnt(0)" ::: "memory");
}
__device__ __forceinline__ void transpose_matrix(const float* W, int K, int N, int ldn, bf16_t* WT, const float* gain, int mode, int bitem, LAS float* scr, int wid, int lane) {
    const int nblk = N / 64, kg = bitem / nblk, nb = bitem % nblk, kbk = kg * 8 + wid;
    if (kbk * 64 >= K) return;
    const int n0 = 64 * nb; int drow0 = n0;
    if (mode == 1) { const int isb = n0 >= FF, f = n0 - isb * FF; drow0 = (f >> 7) * 256 + isb * 128 + (f & 127); }
    transpose_tile64(W, K, ldn, WT, gain, kbk * 64, n0, drow0, scr, lane);
}
__device__ __forceinline__ void phase_prep(const Args& a, LAS unsigned char* lds, int G) {
    const int tid = threadIdx.x, wid = tid >> 6, lane = tid & 63;
    unsigned char* ws = a.ws;
    LAS float* scr = (LAS float*)(lds + wid * 16640);
    const int gw = blockIdx.x * NWAVES + wid, NGW = G * NWAVES;
    constexpr int B_GU = (2 * FF / 64) * (DM / 512), B_DN = (DM / 64) * ((FF / 64 + 7) / 8), B_HI = (HG_N / 64) * (DM / 512), B_O = (DM / 64) * (DM / 512), B_FI = (8192 / 64) * (DM / 512);
    constexpr int NBITEMS = 4 * B_GU + 4 * B_DN + B_HI + B_O + B_FI + B_O;
    for (int it = blockIdx.x; it < NBITEMS; it += G) {
        int r = it;
        if (r < 4 * B_GU) { const int w = r / B_GU; r -= w * B_GU; const int layer = w >> 1, j = w & 1;
            transpose_matrix(a.w_gu + (size_t)w * DM * 2 * FF, DM, 2 * FF, 2 * FF, (bf16_t*)(ws + WS_WGU + w * SZ_WGU1), a.norm_g + (layer * 3 + (j ? 2 : 0)) * DM, 1, r, scr, wid, lane); continue; }
        r -= 4 * B_GU;
        if (r < 4 * B_DN) { const int w = r / B_DN; r -= w * B_DN; if (r < NDEFER_DN) continue;
            transpose_matrix(a.w_dn + (size_t)w * FF * DM, FF, DM, DM, (bf16_t*)(ws + WS_WDN + w * SZ_WDN1), nullptr, 0, r, scr, wid, lane); continue; }
        r -= 4 * B_DN;
        if (r < B_HI) { transpose_matrix(a.hg_w_in, DM, HG_N, HG_N, (bf16_t*)(ws + WS_WHI), a.norm_g + (0 * 3 + 1) * DM, 0, r, scr, wid, lane); continue; }
        r -= B_HI;
        if (r < B_O) { transpose_matrix(a.hg_w_out, DM, DM, DM, (bf16_t*)(ws + WS_WHO), nullptr, 0, r, scr, wid, lane); continue; }
        r -= B_O;
        if (r < B_FI) { transpose_matrix(a.fox_w_in, DM, 8192, FX_NREAL, (bf16_t*)(ws + WS_WFI), a.norm_g + (1 * 3 + 1) * DM, 0, r, scr, wid, lane); continue; }
        r -= B_FI;
        transpose_matrix(a.fox_w_out, DM, DM, DM, (bf16_t*)(ws + WS_WFO), nullptr, 0, r, scr, wid, lane);
    }
    { const int gt = blockIdx.x * NTHREADS + tid, NT = G * NTHREADS; bf16_t* WT = (bf16_t*)(ws + WS_WFI); const float* gain = a.norm_g + (1 * 3 + 1) * DM;
      for (int e = gt; e < 256 * DM; e += NT) { const int n = e / DM, k = e % DM; float v = 0.f; if (n < 16) v = a.fox_w_in[(size_t)k * FX_NREAL + 8192 + n] * gain[k];
          WT[(size_t)(8192 + n) * DM + k] = (bf16_t)(cvtpk(v, 0.f) & 0xffffu); }
      for (int e = gt; e < DM; e += NT) { const float l0 = a.lb_logits[e], l1 = a.lb_logits[DM + e], l2 = a.lb_logits[2 * DM + e]; const float mx = fmaxf(l0, fmaxf(l1, l2));
          const float e0 = fexp(l0 - mx), e1 = fexp(l1 - mx), e2 = fexp(l2 - mx); ((float*)(ws + WS_LB))[e] = e0 / (e0 + e1 + e2); }
      float* ssq = (float*)(ws + WS_SSQ);
      for (int e = gt; e < 5 * TR; e += NT) ssq[TR + e] = 0.f;
      }
    bf16_t* HB = (bf16_t*)(ws + WS_HB); float* ssq0 = (float*)(ws + WS_SSQ);
    for (int rg = blockIdx.x; rg < TR / 32; rg += G)
    for (int jr = 0; jr < 4; ++jr) { const int r = rg * 32 + wid * 4 + jr;
        const float* src = r >= ROW_X ? a.x + (size_t)(r - ROW_X) * DM : (r >= ROW_META ? a.meta + (size_t)(r - ROW_META) * DM : nullptr);
        float s = 0.f;
#pragma unroll
        for (int j = 0; j < 8; ++j) { f32x4 v = src ? *(const f32x4*)(src + j * 256 + lane * 4) : (f32x4){0.f, 0.f, 0.f, 0.f};
            u32x2 w; w.x = cvtpk(v[0], v[1]); w.y = cvtpk(v[2], v[3]); *(u32x2*)(HB + (size_t)r * DM + j * 256 + lane * 4) = w;
            s += (v[0] * v[0] + v[1] * v[1]) + (v[2] * v[2] + v[3] * v[3]); }
        s = wave_sum(s); if (lane == 0) ssq0[r] = s;
    }
}

#define TRRD2(d0, d1, a0_, a1_) asm volatile("ds_read_b64_tr_b16 %0, %2\n\tds_read_b64_tr_b16 %1, %3\n\ts_waitcnt lgkmcnt(0)" : "=&v"(d0), "=&v"(d1) : "v"(a0_), "v"(a1_) : "memory")
#define TRRD16(D, b0_, b1_) asm volatile( \
    "ds_read_b64_tr_b16 %0, %16\n\tds_read_b64_tr_b16 %1, %17\n\t" \
    "ds_read_b64_tr_b16 %2, %16 offset:32\n\tds_read_b64_tr_b16 %3, %17 offset:32\n\t" \
    "ds_read_b64_tr_b16 %4, %16 offset:64\n\tds_read_b64_tr_b16 %5, %17 offset:64\n\t" \
    "ds_read_b64_tr_b16 %6, %16 offset:96\n\tds_read_b64_tr_b16 %7, %17 offset:96\n\t" \
    "ds_read_b64_tr_b16 %8, %16 offset:128\n\tds_read_b64_tr_b16 %9, %17 offset:128\n\t" \
    "ds_read_b64_tr_b16 %10, %16 offset:160\n\tds_read_b64_tr_b16 %11, %17 offset:160\n\t" \
    "ds_read_b64_tr_b16 %12, %16 offset:192\n\tds_read_b64_tr_b16 %13, %17 offset:192\n\t" \
    "ds_read_b64_tr_b16 %14, %16 offset:224\n\tds_read_b64_tr_b16 %15, %17 offset:224\n\t" \
    "s_waitcnt lgkmcnt(0)" \
    : "=&v"(D[0]), "=&v"(D[1]), "=&v"(D[2]), "=&v"(D[3]), "=&v"(D[4]), "=&v"(D[5]), "=&v"(D[6]), "=&v"(D[7]), \
      "=&v"(D[8]), "=&v"(D[9]), "=&v"(D[10]), "=&v"(D[11]), "=&v"(D[12]), "=&v"(D[13]), "=&v"(D[14]), "=&v"(D[15]) \
    : "v"(b0_), "v"(b1_) : "memory")
constexpr int VPITCH = 288;
__device__ __forceinline__ bf16x8 join4(s16x4 a, s16x4 b) { return (bf16x8){a[0], a[1], a[2], a[3], b[0], b[1], b[2], b[3]}; }
__device__ __forceinline__ void stage_tile128(const bf16_t* src, LAS unsigned char* dst, int tid) {
#pragma unroll
    for (int k = 0; k < 4; ++k) { const int id = tid + NTHREADS * k, row = id >> 4, cc = id & 15; const u32x4 v = *(const u32x4*)(src + (size_t)row * DM + cc * 8); *(LAS u32x4*)(dst + row * VPITCH + cc * 16) = v; }
}
constexpr int SPITCH = 272;
__device__ __forceinline__ void stage_state(const bf16_t* src, LAS unsigned char* dst, int tid) {
#pragma unroll
    for (int k = 0; k < 4; ++k) { const int id = tid + NTHREADS * k, row = id >> 4, cc = id & 15; const u32x4 v = *(const u32x4*)(src + (size_t)row * HD + cc * 8); *(LAS u32x4*)(dst + row * SPITCH + cc * 16) = v; }
}
__device__ __forceinline__ void phase_h1(const Args& a, LAS unsigned char* lds, int G) {
    const int tid = threadIdx.x, wid = __builtin_amdgcn_readfirstlane(tid >> 6), lane = tid & 63, i16 = lane & 15, g = lane >> 4;
    unsigned char* ws = a.ws; float* LF = (float*)(ws + WS_LF); const bf16_t* KBp = (const bf16_t*)(ws + WS_KB); const bf16_t* VBp = (const bf16_t*)(ws + WS_VB);
    bf16_t* UT = (bf16_t*)(ws + WS_UT); float* DEC = (float*)(ws + WS_DEC);
    LAS unsigned char* Vs = lds; LAS unsigned char* Ks = lds + 128 * VPITCH; LAS float* tot = (LAS float*)(lds + 2 * 128 * VPITCH);
    for (int item = blockIdx.x; item < NCHUNK * NH; item += G) {
        const int c = item / NH, h = item % NH, R0 = c * 128;
        const int d = tid & 127, part = tid >> 7;
        float* lfp = LF + (size_t)(R0 + 32 * part) * DM + h * HD + d; const bf16_t* kp = KBp + (size_t)(R0 + 32 * part) * DM + h * HD + d;
        float bl[32]; float run = 0.f;
#pragma unroll
        for (int i = 0; i < 32; ++i) { run += lfp[(size_t)i * DM]; bl[i] = run; }
        tot[part * 128 + d] = run;
        stage_tile128(VBp + (size_t)R0 * DM + h * HD, Vs, tid);
        __syncthreads();
        const float t0 = tot[d], t1 = tot[128 + d], t2 = tot[256 + d], t3 = tot[384 + d];
        const float off = part == 0 ? 0.f : part == 1 ? t0 : part == 2 ? t0 + t1 : t0 + t1 + t2; const float blast = (t0 + t1) + (t2 + t3);
#pragma unroll
        for (int i = 0; i < 32; ++i) { const float b = bl[i] + off; lfp[(size_t)i * DM] = b; const float kv = bf2f(kp[(size_t)i * DM]) * fexp(blast - b);
            *(LAS bf16_t*)(Ks + (32 * part + i) * VPITCH + d * 2) = (bf16_t)(cvtpk(kv, 0.f) & 0xffffu); }
        if (part == 0) DEC[(size_t)(c * NH + h) * HD + d] = fexp(blast);
        __syncthreads();
        f32x4 acc[8];
#pragma unroll
        for (int n = 0; n < 8; ++n) acc[n] = (f32x4){0.f, 0.f, 0.f, 0.f};
        const int rsel = 4 * g + (i16 >> 2), csel = 4 * (i16 & 3);
#pragma unroll
        for (int ks = 0; ks < 4; ++ks) { const int s0 = 32 * ks;
            s16x4 a0, a1; TRRD2(a0, a1, (unsigned)(uintptr_t)(Vs + (s0 + rsel) * VPITCH + (16 * wid + csel) * 2), (unsigned)(uintptr_t)(Vs + (s0 + 16 + rsel) * VPITCH + (16 * wid + csel) * 2));
            const bf16x8 af = join4(a0, a1);
            s16x4 bd[16]; TRRD16(bd, (unsigned)(uintptr_t)(Ks + (s0 + rsel) * VPITCH + csel * 2), (unsigned)(uintptr_t)(Ks + (s0 + 16 + rsel) * VPITCH + csel * 2));
#pragma unroll
            for (int n = 0; n < 8; ++n) acc[n] = __builtin_amdgcn_mfma_f32_16x16x32_bf16(af, join4(bd[2 * n], bd[2 * n + 1]), acc[n], 0, 0, 0); }
        bf16_t* up = UT + ((size_t)(c * NH + h) * HD + 16 * wid + 4 * g) * HD + i16;
#pragma unroll
        for (int n = 0; n < 8; ++n)
#pragma unroll
            for (int r = 0; r < 4; ++r) up[(size_t)r * HD + 16 * n] = (bf16_t)(cvtpk(acc[n][r], 0.f) & 0xffffu);
        __syncthreads();
    }
}
__device__ __forceinline__ void phase_h2(const Args& a, int G) {
    unsigned char* ws = a.ws; const bf16_t* UT = (const bf16_t*)(ws + WS_UT); const float* DEC = (const float*)(ws + WS_DEC); bf16_t* ST = (bf16_t*)(ws + WS_ST);
    for (int e = blockIdx.x * NTHREADS + threadIdx.x; e < NH * HD * 64; e += G * NTHREADS) {
        const int hv = e >> 6, dp = e & 63, h = hv >> 7, v = hv & 127, d = 2 * dp;
        f32x2 S = {0.f, 0.f};
        for (int c0 = 0; c0 < NCHUNK; c0 += 10) {
            f32x2 u[10], dc[10];
#pragma unroll
            for (int k = 0; k < 10; ++k) { const int c = c0 + k; { const unsigned uw = *(const unsigned*)(UT + ((size_t)(c * NH + h) * HD + v) * HD + d); u[k] = (f32x2){bflo(uw), bfhi(uw)}; } dc[k] = *(const f32x2*)(DEC + (size_t)(c * NH + h) * HD + d); }
#pragma unroll
            for (int k = 0; k < 10; ++k) { const int c = c0 + k; *(unsigned*)(ST + ((size_t)(c * NH + h) * HD + v) * HD + d) = cvtpk(S[0], S[1]); S = dc[k] * S + u[k]; }
        }
    }
}
__device__ __forceinline__ void phase_h3(const Args& a, LAS unsigned char* lds, int G) {
    const int tid = threadIdx.x, wid = __builtin_amdgcn_readfirstlane(tid >> 6), lane = tid & 63, i16 = lane & 15, g = lane >> 4;
    unsigned char* ws = a.ws; const float* Bb = (const float*)(ws + WS_LF); const bf16_t* QBp = (const bf16_t*)(ws + WS_QB); const bf16_t* KBp = (const bf16_t*)(ws + WS_KB);
    const bf16_t* VBp = (const bf16_t*)(ws + WS_VB); const bf16_t* GBp = (const bf16_t*)(ws + WS_GB); const bf16_t* ST = (const bf16_t*)(ws + WS_ST); bf16_t* OG = (bf16_t*)(ws + WS_OG);
    constexpr int NPAIR = (NCHUNK - 2) * NH / 2;
    for (int pw = blockIdx.x; pw < NPAIR + NH; pw += G) {
        const bool metaitem = pw >= NPAIR;
        { const int it0 = metaitem ? NH + (pw - NPAIR) : 2 * NH + 2 * pw; const int c0 = it0 / NH, h0 = it0 % NH;
          stage_tile128(VBp + (size_t)(c0 * 128) * DM + h0 * HD, lds, tid);
          stage_state(ST + (size_t)(c0 * NH + h0) * HD * HD, lds + 2 * 128 * VPITCH, tid);
          if (!metaitem) { const int it1 = it0 + 1, c1 = it1 / NH, h1 = it1 % NH; stage_tile128(VBp + (size_t)(c1 * 128) * DM + h1 * HD, lds + 128 * VPITCH, tid);
              stage_state(ST + (size_t)(c1 * NH + h1) * HD * HD, lds + 2 * 128 * VPITCH + 128 * SPITCH, tid); } }
        __syncthreads();
      for (int half = 0; half < (metaitem ? 1 : 2); ++half) {
        const int item = metaitem ? NH + (pw - NPAIR) : 2 * NH + 2 * pw + half;
        const int c = item / NH, h = item % NH, R0 = c * 128;
        const int I = metaitem ? 7 : (half ? 7 - wid : wid);
        if (metaitem && wid != 7) continue;
        LAS unsigned char* Vs = lds + half * (128 * VPITCH);
        const size_t hb = (size_t)h * HD;
        f32x4 br[4][2];
#pragma unroll
        for (int ks = 0; ks < 4; ++ks) { const float* p = Bb + (size_t)(R0 + 16 * I - 1) * DM + hb + 32 * ks + 8 * g;
            if (I > 0) { br[ks][0] = *(const f32x4*)p; br[ks][1] = *(const f32x4*)(p + 4); } else { br[ks][0] = (f32x4){0.f, 0.f, 0.f, 0.f}; br[ks][1] = br[ks][0]; } }
        bf16x8 qf[4], qh[4];
        { const size_t ro = (size_t)(R0 + 16 * I + i16) * DM + hb + 8 * g;
#pragma unroll
          for (int ks = 0; ks < 4; ++ks) { const u32x4 q8 = *(const u32x4*)(QBp + ro + 32 * ks); const f32x4 b0 = *(const f32x4*)(Bb + ro + 32 * ks), b1 = *(const f32x4*)(Bb + ro + 32 * ks + 4);
              float qv[8] = {bflo(q8.x), bfhi(q8.x), bflo(q8.y), bfhi(q8.y), bflo(q8.z), bfhi(q8.z), bflo(q8.w), bfhi(q8.w)}; float x1[8], x2[8];
#pragma unroll
              for (int j = 0; j < 8; ++j) { const float bt = j < 4 ? b0[j] : b1[j - 4], rf = j < 4 ? br[ks][0][j] : br[ks][1][j - 4]; x1[j] = qv[j] * fexp(bt - rf); x2[j] = qv[j] * fexp(bt); }
              u32x4 w1 = {cvtpk(x1[0], x1[1]), cvtpk(x1[2], x1[3]), cvtpk(x1[4], x1[5]), cvtpk(x1[6], x1[7])}; u32x4 w2 = {cvtpk(x2[0], x2[1]), cvtpk(x2[2], x2[3]), cvtpk(x2[4], x2[5]), cvtpk(x2[6], x2[7])};
              qf[ks] = *reinterpret_cast<bf16x8*>(&w1); qh[ks] = *reinterpret_cast<bf16x8*>(&w2); } }
        f32x4 o[8];
#pragma unroll
        for (int n = 0; n < 8; ++n) o[n] = (f32x4){0.f, 0.f, 0.f, 0.f};
        { const LAS unsigned char* sp = lds + 2 * 128 * VPITCH + half * (128 * SPITCH) + i16 * SPITCH + 16 * g;
#pragma unroll
          for (int ks = 0; ks < 4; ++ks)
#pragma unroll
              for (int n = 0; n < 8; ++n) { const bf16x8 sf = *(const LAS bf16x8*)(sp + (16 * n) * SPITCH + 64 * ks); o[n] = __builtin_amdgcn_mfma_f32_16x16x32_bf16(qh[ks], sf, o[n], 0, 0, 0); } }
        const int rsel = 4 * g + (i16 >> 2), csel = 4 * (i16 & 3);
        u32x2 pA = {0u, 0u};
        for (int J = metaitem ? 7 : 0; J <= I; ++J) {
            f32x4 sacc = {0.f, 0.f, 0.f, 0.f};
            const size_t ro = (size_t)(R0 + 16 * J + i16) * DM + hb + 8 * g;
#pragma unroll
            for (int ks = 0; ks < 4; ++ks) { const u32x4 k8 = *(const u32x4*)(KBp + ro + 32 * ks); const f32x4 b0 = *(const f32x4*)(Bb + ro + 32 * ks), b1 = *(const f32x4*)(Bb + ro + 32 * ks + 4);
                float kv[8] = {bflo(k8.x), bfhi(k8.x), bflo(k8.y), bfhi(k8.y), bflo(k8.z), bfhi(k8.z), bflo(k8.w), bfhi(k8.w)}; float x1[8];
#pragma unroll
                for (int j = 0; j < 8; ++j) { const float bs = j < 4 ? b0[j] : b1[j - 4], rf = j < 4 ? br[ks][0][j] : br[ks][1][j - 4]; x1[j] = kv[j] * fexp(fminf(rf - bs, 80.f)); }
                u32x4 w1 = {cvtpk(x1[0], x1[1]), cvtpk(x1[2], x1[3]), cvtpk(x1[4], x1[5]), cvtpk(x1[6], x1[7])};
                sacc = __builtin_amdgcn_mfma_f32_16x16x32_bf16(*reinterpret_cast<bf16x8*>(&w1), qf[ks], sacc, 0, 0, 0); }
            if (J == I) {
#pragma unroll
                for (int r = 0; r < 4; ++r) if (4 * g + r > i16) sacc[r] = 0.f; }
            u32x2 pk = {cvtpk(sacc[0], sacc[1]), cvtpk(sacc[2], sacc[3])};
            if ((J & 1) == 0 && J < I) { pA = pk; continue; }
            u32x2 pB; int sA, sB;
            if (J & 1) { pB = pk; sA = 16 * (J - 1); sB = 16 * J; } else { pA = pk; pB = (u32x2){0u, 0u}; sA = 16 * J; sB = 16 * J; }
            u32x4 pw = {pA.x, pA.y, pB.x, pB.y}; const bf16x8 pf = *reinterpret_cast<bf16x8*>(&pw);
            s16x4 vd[16]; TRRD16(vd, (unsigned)(uintptr_t)(Vs + (sA + rsel) * VPITCH + csel * 2), (unsigned)(uintptr_t)(Vs + (sB + rsel) * VPITCH + csel * 2));
#pragma unroll
            for (int n = 0; n < 8; ++n) o[n] = __builtin_amdgcn_mfma_f32_16x16x32_bf16(pf, join4(vd[2 * n], vd[2 * n + 1]), o[n], 0, 0, 0);
        }
        float rn[4];
#pragma unroll
        for (int r = 0; r < 4; ++r) { float s = 0.f;
#pragma unroll
            for (int n = 0; n < 8; ++n) s += o[n][r] * o[n][r];
            s += __shfl_xor(s, 1); s += __shfl_xor(s, 2); s += __shfl_xor(s, 4); s += __shfl_xor(s, 8);
            rn[r] = __builtin_amdgcn_rsqf(s * (1.0f / HD) + RMS_EPS); }
#pragma unroll
        for (int n = 0; n < 8; ++n) { const float on = a.hg_onorm[16 * n + i16];
#pragma unroll
            for (int r = 0; r < 4; ++r) { const size_t off = (size_t)(R0 + 16 * I + 4 * g + r) * DM + hb + 16 * n + i16;
                const float val = o[n][r] * rn[r] * on * bf2f(GBp[off]); OG[off] = (bf16_t)(cvtpk(val, 0.f) & 0xffffu); } }
      }
        __syncthreads();
    }
}

__device__ __forceinline__ void phase_x2(const Args& a, int G) {
    const int tid = threadIdx.x, wid = tid >> 6, lane = tid & 63;
    unsigned char* ws = a.ws;
    const float* LFX = (const float*)(ws + WS_LFX); float* LOC = (float*)(ws + WS_LOC); float* SEG = (float*)(ws + WS_SEG);
    const int gw = blockIdx.x * NWAVES + wid, NGW = G * NWAVES;
    if (gw < NCHUNK) {
        const int sg = gw, hh = lane & 15, part = lane >> 4; float v[32]; float run = 0.f;
#pragma unroll
        for (int i = 0; i < 32; ++i) { const int r = sg * 128 + part * 32 + i; const float x = r >= ROW_META ? LFX[(size_t)r * 16 + hh] : 0.f; run += x; v[i] = run; }
        const float t0 = __shfl(run, hh), t1 = __shfl(run, 16 + hh), t2 = __shfl(run, 32 + hh), t3 = __shfl(run, 48 + hh);
        const float off = part == 0 ? 0.f : part == 1 ? t0 : part == 2 ? t0 + t1 : t0 + t1 + t2;
#pragma unroll
        for (int i = 0; i < 32; ++i) LOC[(size_t)(sg * 128 + part * 32 + i) * 16 + hh] = v[i] + off;
        if (part == 0) SEG[sg * 16 + hh] = (t0 + t1) + (t2 + t3);
    }
    bf16_t* KBp = (bf16_t*)(ws + WS_KB);
    for (int r = ROW_META + gw; r < TR; r += NGW) {
#pragma unroll
        for (int p = 0; p < 4; ++p) { bf16_t* ptr = KBp + (size_t)r * DM + p * 512 + lane * 8; const u32x4 w = *(const u32x4*)ptr;
            float x[8] = {bflo(w.x), bfhi(w.x), bflo(w.y), bfhi(w.y), bflo(w.z), bfhi(w.z), bflo(w.w), bfhi(w.w)}; float sk = 0.f;
#pragma unroll
            for (int j = 0; j < 8; ++j) sk += x[j] * x[j];
            sk += __shfl_xor(sk, 1); sk += __shfl_xor(sk, 2); sk += __shfl_xor(sk, 4); sk += __shfl_xor(sk, 8);
            const float rn = __builtin_amdgcn_rsqf(sk * (1.0f / HD) + RMS_EPS); const float* gp = a.fox_knorm + (lane & 15) * 8;
#pragma unroll
            for (int j = 0; j < 8; ++j) x[j] = x[j] * rn * gp[j];
            u32x4 o = {cvtpk(x[0], x[1]), cvtpk(x[2], x[3]), cvtpk(x[4], x[5]), cvtpk(x[6], x[7])}; *(u32x4*)ptr = o; }
    }
}

namespace att {
constexpr float SCALE = 0.08838834764831845f, INV_SCALE = 11.313708498984761f, THR = 8.f;
constexpr int QBLK = 32, KVBLK = 64, QB = 256, SHM_V = KVBLK * HD * 2, SHM_K = KVBLK * HD * 2;
#define KSWZ(row, colB) ((row) * 256 + ((colB) ^ (((row) & 7) << 4)))
#define SBAR() __builtin_amdgcn_sched_barrier(0)
__device__ __forceinline__ int v_st(int k, int c) { const int kk = (k & ~0xC) | ((k & 4) << 1) | ((k & 8) >> 1); return ((kk >> 3) * 4 + (c >> 5)) * 512 + ((kk & 7) * 32 + (c & 31)) * 2; }
__device__ __forceinline__ int v_rd_base(int lane) { return ((lane & 3) << 3) | (((lane >> 2) & 3) << 6) | (((lane >> 4) & 1) << 5) | (((lane >> 5) & 1) << 8); }
constexpr int v_rd_off(int d0, int ks, int half) { return d0 * 512 + ks * 4096 + half * 2048; }
__device__ __forceinline__ int crow(int r, int hi) { return (r & 3) + 8 * (r >> 2) + 4 * hi; }
__device__ __forceinline__ void mask_tile(f32x16& p0, f32x16& p1, int dq, unsigned W) {
    const float NEG = -__builtin_inff();
#pragma unroll
    for (int r = 0; r < 16; ++r) { const int c = (r & 3) + 8 * (r >> 2);
        if ((unsigned)(dq - c) >= W) p0[r] = NEG;
        if ((unsigned)(dq - c - 32) >= W) p1[r] = NEG; }
}
__device__ __forceinline__ void partialSM(f32x16& p0, f32x16& p1, float& m_reg, float& mn, float& alpha) {
    float pmax = p0[0];
#pragma unroll
    for (int r = 1; r < 16; ++r) pmax = fmaxf(pmax, p0[r]);
#pragma unroll
    for (int r = 0; r < 16; ++r) pmax = fmaxf(pmax, p1[r]);
    { auto rr = __builtin_amdgcn_permlane32_swap(__float_as_uint(pmax), __float_as_uint(pmax), false, false); pmax = fmaxf(__uint_as_float(rr[0]), __uint_as_float(rr[1])); }
    constexpr float C2 = 1.4426950408889634f * SCALE;
    if (__builtin_expect(__all((pmax - m_reg) * SCALE <= THR), 1)) { mn = m_reg; alpha = 1.f; }
    else { mn = fmaxf(m_reg, pmax); alpha = __builtin_amdgcn_exp2f((m_reg - mn) * C2); m_reg = mn; }
    const float mnL = -mn * C2;
#pragma unroll
    for (int r = 0; r < 16; ++r) p0[r] = fmaf(p0[r], C2, mnL);
#pragma unroll
    for (int r = 0; r < 16; ++r) p1[r] = fmaf(p1[r], C2, mnL);
#pragma unroll
    for (int r = 0; r < 16; ++r) p0[r] = __builtin_amdgcn_exp2f(p0[r]);
}
__device__ __forceinline__ void finishSM(f32x16& p0, f32x16& p1, float alpha, float& l_reg, bf16x8& pa0, bf16x8& pa1, bf16x8& pa2, bf16x8& pa3) {
#pragma unroll
    for (int r = 0; r < 16; ++r) p1[r] = __builtin_amdgcn_exp2f(p1[r]);
    float ps = 0;
#pragma unroll
    for (int r = 0; r < 16; ++r) ps += p0[r];
#pragma unroll
    for (int r = 0; r < 16; ++r) ps += p1[r];
    { auto rr = __builtin_amdgcn_permlane32_swap(__float_as_uint(ps), __float_as_uint(ps), false, false); ps = __uint_as_float(rr[0]) + __uint_as_float(rr[1]); }
    l_reg = l_reg * alpha + ps;
#define PK4(P, B_, OUT) do { unsigned a0 = cvtpk(P[B_+0], P[B_+1]), a1 = cvtpk(P[B_+2], P[B_+3]); unsigned b0 = cvtpk(P[B_+4], P[B_+5]), b1 = cvtpk(P[B_+6], P[B_+7]); \
        auto r0 = __builtin_amdgcn_permlane32_swap(a0, b0, false, false); auto r1 = __builtin_amdgcn_permlane32_swap(a1, b1, false, false); \
        u32x4 w = {r0[0], r1[0], r0[1], r1[1]}; OUT = *reinterpret_cast<bf16x8*>(&w); } while (0)
    PK4(p0, 0, pa0); PK4(p0, 8, pa1); PK4(p1, 0, pa2); PK4(p1, 8, pa3);
#undef PK4
}
__device__ __forceinline__ void qkt(f32x16& p0, f32x16& p1, const char* Kb, int r32, int hi, const bf16x8* qr) {
    p0 = f32x16{}; p1 = f32x16{};
    const char* kb[4];
#pragma unroll
    for (int dd = 0; dd < 4; ++dd) kb[dd] = Kb + KSWZ(r32, (dd * 16 + hi * 8) * 2);
#pragma unroll
    for (int d0 = 0; d0 < 8; ++d0) { const char* ap = kb[d0 & 3] + (d0 >> 2) * 128;
        bf16x8 b0 = *reinterpret_cast<const bf16x8*>(ap);
        bf16x8 b1 = *reinterpret_cast<const bf16x8*>(ap + 32 * 256);
        p0 = __builtin_amdgcn_mfma_f32_32x32x16_bf16(b0, qr[d0], p0, 0, 0, 0);
        p1 = __builtin_amdgcn_mfma_f32_32x32x16_bf16(b1, qr[d0], p1, 0, 0, 0); }
}
__device__ __forceinline__ void pv_tile(f32x16* o, int vb0, bf16x8 pa0, bf16x8 pa1, bf16x8 pa2, bf16x8 pa3) {
#define TRRDO(dst, off) asm volatile("ds_read_b64_tr_b16 %0, %1 offset:%2" : "=&v"(dst) : "v"(vb0), "i"(off) : "memory")
#define PV_D0(d0) do { s16x4 l0, l1, l2, l3, h0, h1, h2, h3; constexpr int b_ = v_rd_off(d0, 0, 0); \
        TRRDO(l0, b_); TRRDO(h0, b_ + 2048); TRRDO(l1, b_ + 4096); TRRDO(h1, b_ + 6144); TRRDO(l2, b_ + 8192); TRRDO(h2, b_ + 10240); TRRDO(l3, b_ + 12288); TRRDO(h3, b_ + 14336); \
        asm volatile("s_waitcnt lgkmcnt(0)" ::: "memory"); SBAR(); \
        o[d0] = __builtin_amdgcn_mfma_f32_32x32x16_bf16(pa0, (bf16x8){l0[0], l0[1], l0[2], l0[3], h0[0], h0[1], h0[2], h0[3]}, o[d0], 0, 0, 0); \
        o[d0] = __builtin_amdgcn_mfma_f32_32x32x16_bf16(pa1, (bf16x8){l1[0], l1[1], l1[2], l1[3], h1[0], h1[1], h1[2], h1[3]}, o[d0], 0, 0, 0); \
        o[d0] = __builtin_amdgcn_mfma_f32_32x32x16_bf16(pa2, (bf16x8){l2[0], l2[1], l2[2], l2[3], h2[0], h2[1], h2[2], h2[3]}, o[d0], 0, 0, 0); \
        o[d0] = __builtin_amdgcn_mfma_f32_32x32x16_bf16(pa3, (bf16x8){l3[0], l3[1], l3[2], l3[3], h3[0], h3[1], h3[2], h3[3]}, o[d0], 0, 0, 0); } while (0)
    PV_D0(0); PV_D0(1); PV_D0(2); PV_D0(3);
#undef PV_D0
#undef TRRDO
}
}

__device__ __forceinline__ void phase_x3(const Args& a, unsigned char* ldsg, int G) {
    using namespace att;
    const int tid = threadIdx.x, wid = __builtin_amdgcn_readfirstlane(tid >> 6), lane = tid & 63, r32 = lane & 31, hi = lane >> 5;
    unsigned char* ws = a.ws; const bf16_t* QBp = (const bf16_t*)(ws + WS_QB); const bf16_t* KBp = (const bf16_t*)(ws + WS_KB); const bf16_t* VBp = (const bf16_t*)(ws + WS_VB);
    const bf16_t* GBp = (const bf16_t*)(ws + WS_GB); bf16_t* OG = (bf16_t*)(ws + WS_OG); const float* LOC = (const float*)(ws + WS_LOC); const float* SEG = (const float*)(ws + WS_SEG); const float* RKp = (const float*)(ws + WS_RK);
    char* V_lds = (char*)ldsg; char* K_lds = (char*)ldsg + 2 * SHM_V;
    float* wsf = (float*)(ldsg + 2 * SHM_V + 2 * SHM_K) + wid * 64; float* li_l = wsf, * al_l = wsf + 32;
    float* ck_l = (float*)(ldsg + 2 * SHM_V + 2 * SHM_K + 2048);
    float* rk_l = ck_l + 128;
    float* cseg = rk_l + 128;
    int* misc = (int*)(cseg + 136);
    float* g2_l = (float*)(misc + 4);
    if (tid < HD) g2_l[tid] = a.fox_qnorm[tid];
    int ksr[2], ksc[2], vsr[2], vsc[2];
#pragma unroll
    for (int i = 0; i < 2; ++i) { const int q = i * 512 + tid; const int row = q >> 4, cpos = q & 15; ksr[i] = row; ksc[i] = ((cpos ^ (row & 7)) * 8);
        const int st = q >> 5, w = q & 31, kkl = w >> 2, cch = w & 3, kk = (st >> 2) * 8 + kkl, key = (kk & ~0xC) | ((kk & 4) << 1) | ((kk & 8) >> 1); vsr[i] = key; vsc[i] = (st & 3) * 32 + cch * 8; }
    LAS unsigned char* ldsl = (LAS unsigned char*)ldsg;
    const int vbase = (int)(uintptr_t)V_lds + v_rd_base(lane);
    float gq = 0.f, gk = 0.f; for (int i = 0; i < HD; ++i) { gq = fmaxf(gq, fabsf(a.fox_qnorm[i])); gk = fmaxf(gk, fabsf(a.fox_knorm[i])); }
    const float THRESH = 105.0f + 2.0f * (gq * gk * (float)HD * SCALE) + 1.0f;
    const int NITEM = (TR / QB - 1) * NH;
    for (int item = blockIdx.x; item < NITEM; item += G) {
        const int qb = (TR / QB) - 1 - item / NH, h = item % NH, R0 = qb * QB; const size_t hb = (size_t)h * HD;
        __syncthreads();
        if (wid == 0) {
            float run = 0.f;
            for (int s0 = 0; s0 < NCHUNK; s0 += 64) { const int sg = s0 + lane; float v = sg < NCHUNK ? SEG[sg * 16 + h] : 0.f; float x = v;
#pragma unroll
                for (int o = 1; o < 64; o <<= 1) { const float y = __shfl_up(x, o); if (lane >= o) x += y; }
                if (sg < NCHUNK) cseg[sg] = run + x - v; run += __shfl(x, 63); }
        }
        if (tid == 0) misc[0] = 1 << 30;
        __syncthreads();
        const int j_hi = R0 / KVBLK + 4;
        { const int rq = R0 < ROW_META ? ROW_META : R0; const float c0 = cseg[rq >> 7] + LOC[(size_t)rq * 16 + h];
          if (tid >= 3 && tid < j_hi) { const int e = tid * KVBLK + 63; const float ce = cseg[e >> 7] + LOC[(size_t)e * 16 + h]; if (c0 - ce >= -THRESH) atomicMin(misc, tid); } }
        __syncthreads();
        const int j_lo = misc[0], NT = j_hi - j_lo;
        const int row = R0 + wid * QBLK + r32;
        bf16x8 qr[8];
        { float sq = 0.f;
#pragma unroll
          for (int d0 = 0; d0 < 8; ++d0) { const u32x4 w = *(const u32x4*)(QBp + (size_t)row * DM + hb + d0 * 16 + hi * 8);
              const float x[8] = {bflo(w.x), bfhi(w.x), bflo(w.y), bfhi(w.y), bflo(w.z), bfhi(w.z), bflo(w.w), bfhi(w.w)};
#pragma unroll
              for (int j = 0; j < 8; ++j) sq += x[j] * x[j]; }
          { auto rr = __builtin_amdgcn_permlane32_swap(__float_as_uint(sq), __float_as_uint(sq), false, false); sq = __uint_as_float(rr[0]) + __uint_as_float(rr[1]); }
          const float rq = __builtin_amdgcn_rsqf(sq * (1.0f / HD) + RMS_EPS);
          asm volatile("" ::: "memory");
#pragma unroll
          for (int d0 = 0; d0 < 8; ++d0) { const u32x4 w = *(const u32x4*)(QBp + (size_t)row * DM + hb + d0 * 16 + hi * 8);
              const f32x4 g0 = *(const f32x4*)(g2_l + d0 * 16 + hi * 8), g1 = *(const f32x4*)(g2_l + d0 * 16 + hi * 8 + 4);
              const f32x4 x0 = {bflo(w.x), bfhi(w.x), bflo(w.y), bfhi(w.y)}, x1 = {bflo(w.z), bfhi(w.z), bflo(w.w), bfhi(w.w)};
              qr[d0] = pack8(x0 * rq * g0, x1 * rq * g1); } }
        const int qlo = R0 + wid * QBLK, qm = row - 4 * hi;
        const unsigned Wm = row >= ROW_META ? (unsigned)(row - (ROW_META - 1)) : 1u;
        float m_reg = -1e30f, l_reg = 0.f; f32x16 o[4] = {};
        float st_c = 0.f;
#define KDMA(kb_, bf) do { _Pragma("unroll") for (int i_ = 0; i_ < 2; ++i_) \
        __builtin_amdgcn_global_load_lds((const unsigned*)(KBp + (size_t)((kb_) + ksr[i_]) * DM + hb + ksc[i_]), (LAS unsigned*)(ldsl + 2 * SHM_V + (bf) * SHM_K + (i_ * 512 + wid * 64) * 16), 16, 0, 0); } while (0)
#define VDMA(kb_, bf) do { _Pragma("unroll") for (int i_ = 0; i_ < 2; ++i_) \
        __builtin_amdgcn_global_load_lds((const unsigned*)(VBp + (size_t)((kb_) + vsr[i_]) * DM + hb + vsc[i_]), (LAS unsigned*)(ldsl + (bf) * SHM_V + (i_ * 512 + wid * 64) * 16), 16, 0, 0); } while (0)
#define CLOAD(kb_) do { if (tid < 64) { st_c = (cseg[((kb_) + tid) >> 7] + LOC[(size_t)((kb_) + tid) * 16 + h]) * INV_SCALE; } } while (0)
#define CWRITE(bf) do { if (tid < 64) { ck_l[(bf) * 64 + tid] = st_c; } } while (0)
#define BIASMASK(P0, P1, t_, bf) do { const int kb_ = (j_lo + (t_)) * KVBLK; const float* ckb = ck_l + (bf) * 64 + 4 * hi; \
        _Pragma("unroll") for (int gI = 0; gI < 4; ++gI) { { const f32x4 c0 = *(const f32x4*)(ckb + 8 * gI); \
            _Pragma("unroll") for (int j = 0; j < 4; ++j) P0[4 * gI + j] -= c0[j]; } SBAR(); \
            { const f32x4 c1 = *(const f32x4*)(ckb + 32 + 8 * gI); \
            _Pragma("unroll") for (int j = 0; j < 4; ++j) P1[4 * gI + j] -= c1[j]; } SBAR(); } \
        if (kb_ + KVBLK - 1 > qlo || kb_ < ROW_META) mask_tile(P0, P1, qm - kb_, Wm); } while (0)
        KDMA(j_lo * KVBLK, 0); VDMA(j_lo * KVBLK, 0); CLOAD(j_lo * KVBLK); CWRITE(0);
        if (NT > 1) { KDMA((j_lo + 1) * KVBLK, 1); CLOAD((j_lo + 1) * KVBLK); CWRITE(1); }
        asm volatile("s_waitcnt vmcnt(0)" ::: "memory");
        __syncthreads();
        f32x16 pA0, pA1, pB0, pB1;
        qkt(pA0, pA1, K_lds, r32, hi, qr); BIASMASK(pA0, pA1, 0, 0);
        __syncthreads();
#define STEP(X0, X1, Y0, Y1, t_, par) do { \
        if ((t_) + 2 < NT) { KDMA((j_lo + (t_) + 2) * KVBLK, par); CLOAD((j_lo + (t_) + 2) * KVBLK); } \
        if ((t_) + 1 < NT) { VDMA((j_lo + (t_) + 1) * KVBLK, (par) ^ 1); qkt(Y0, Y1, K_lds + ((par) ^ 1) * SHM_K, r32, hi, qr); } \
        float mn, alpha; bf16x8 pa0, pa1, pa2, pa3; \
        partialSM(X0, X1, m_reg, mn, alpha); \
        if (__any(alpha < 1.f)) { if (hi == 0) al_l[r32] = alpha; asm volatile("s_waitcnt lgkmcnt(0)" ::: "memory"); \
            _Pragma("unroll") for (int d_ = 0; d_ < 4; ++d_) _Pragma("unroll") for (int r = 0; r < 16; ++r) o[d_][r] *= al_l[crow(r, hi)]; } \
        finishSM(X0, X1, alpha, l_reg, pa0, pa1, pa2, pa3); \
        pv_tile(o, vbase + (par) * SHM_V, pa0, pa1, pa2, pa3); \
        if ((t_) + 1 < NT) BIASMASK(Y0, Y1, (t_) + 1, (par) ^ 1); \
        if ((t_) + 2 < NT) CWRITE(par); \
        asm volatile("s_waitcnt vmcnt(0)" ::: "memory"); \
        __syncthreads(); } while (0)
        for (int t = 0; t < NT; t += 2) {
            STEP(pA0, pA1, pB0, pB1, t, 0);
            if (t + 1 < NT) STEP(pB0, pB1, pA0, pA1, t + 1, 1);
        }
#undef STEP
#undef BIASMASK
#undef KDMA
#undef VDMA
#undef CLOAD
#undef CWRITE
        if (hi == 0) li_l[r32] = l_reg; asm volatile("s_waitcnt lgkmcnt(0)" ::: "memory");
#pragma unroll
        for (int r = 0; r < 16; ++r) { const int orow = crow(r, hi); const float rli = __builtin_amdgcn_rcpf(li_l[orow]); const int grow = R0 + wid * QBLK + orow; const size_t off = (size_t)grow * DM + hb;
#pragma unroll
            for (int d0 = 0; d0 < 4; ++d0) { float v = o[d0][r] * rli * bf2f(GBp[off + d0 * 32 + r32]); if (grow < ROW_META) v = 0.f;
                const float vn = __shfl_xor(v, 1);
                if ((r32 & 1) == 0) *(unsigned*)(OG + off + d0 * 32 + r32) = cvtpk(v, vn); } }
    }
}


__device__ __forceinline__ bf16_t tobf(float v) { return (bf16_t)(cvtpk(v, 0.f) & 0xffffu); }
template <int NG, class Epi>
__device__ __forceinline__ void skinny_phase(LAS unsigned char* lds, const bf16_t* A16, const bf16_t* Bt, int K, int ntask, const Epi& E, int G, int first = 0) {
    const int tid = threadIdx.x, wid = __builtin_amdgcn_readfirstlane(tid >> 6), lane = tid & 63, c16 = lane & 15, g = lane >> 4;
    LAS f32x4* red = (LAS f32x4*)lds;
    const int nks = K / 32;
    if ((int)blockIdx.x < first) return;
    for (int task = blockIdx.x - first; task < ntask; task += G - first) {
        f32x4 acc[NG][4];
        const bf16_t* ap = A16 + (size_t)c16 * K + 8 * g; const bf16_t* bp[NG];
#pragma unroll
        for (int ng = 0; ng < NG; ++ng) { bp[ng] = Bt + (size_t)(E.brow(task, ng) + c16) * K + 8 * g;
#pragma unroll
            for (int nt = 0; nt < 4; ++nt) acc[ng][nt] = (f32x4){0.f, 0.f, 0.f, 0.f}; }
#pragma unroll 8
        for (int ks = wid; ks < nks; ks += 8) { const bf16x8 av = *(const bf16x8*)(ap + 32 * ks);
#pragma unroll
            for (int ng = 0; ng < NG; ++ng)
#pragma unroll
                for (int nt = 0; nt < 4; ++nt) { const bf16x8 bv = *(const bf16x8*)(bp[ng] + (size_t)(16 * nt) * K + 32 * ks); acc[ng][nt] = __builtin_amdgcn_mfma_f32_16x16x32_bf16(av, bv, acc[ng][nt], 0, 0, 0); } }
#pragma unroll
        for (int ng = 0; ng < NG; ++ng)
#pragma unroll
            for (int nt = 0; nt < 4; ++nt) red[((ng * 4 + nt) * 8 + wid) * 64 + lane] = acc[ng][nt];
        __syncthreads();
        if (wid == 0) {
#pragma unroll
            for (int ng = 0; ng < NG; ++ng)
#pragma unroll
                for (int nt = 0; nt < 4; ++nt) { f32x4 t = red[((ng * 4 + nt) * 8) * 64 + lane];
#pragma unroll
                    for (int w = 1; w < 8; ++w) t += red[((ng * 4 + nt) * 8 + w) * 64 + lane];
                    acc[ng][nt] = t; }
            E(task, acc, c16, g); }
        __syncthreads();
    }
}
struct SkSwiGLU { bf16_t* O; const float* ssq;
    __device__ __forceinline__ int brow(int task, int ng) const { const int f0 = 64 * task; return (f0 >> 7) * 256 + (f0 & 127) + ng * 128; }
    __device__ __forceinline__ void operator()(int task, const f32x4 (&acc)[2][4], int c16, int g) const {
#pragma unroll
        for (int r = 0; r < 4; ++r) { const int R = ROW_META + 4 * g + r; const float rs = row_rs(ssq, R);
#pragma unroll
            for (int nt = 0; nt < 4; ++nt) { const float a = acc[0][nt][r] * rs, b = acc[1][nt][r] * rs; O[(size_t)R * FF + 64 * task + 16 * nt + c16] = tobf(a * b * sigmoidf_(a)); } } } };
struct SkResid { bf16_t* HB; float* ssq_out; float alpha;
    __device__ __forceinline__ int brow(int task, int) const { return 64 * task; }
    __device__ __forceinline__ void operator()(int task, const f32x4 (&acc)[1][4], int c16, int g) const {
#pragma unroll
        for (int r = 0; r < 4; ++r) { const int R = ROW_META + 4 * g + r; float s = 0.f;
#pragma unroll
            for (int nt = 0; nt < 4; ++nt) { const size_t off = (size_t)R * DM + 64 * task + 16 * nt + c16; const float o = bf2f(HB[off]) + alpha * acc[0][nt][r]; HB[off] = tobf(o); s += o * o; }
            s += __shfl_xor(s, 1); s += __shfl_xor(s, 2); s += __shfl_xor(s, 4); s += __shfl_xor(s, 8);
            if (c16 == 0) __hip_atomic_fetch_add(ssq_out + R, s, __ATOMIC_RELAXED, __HIP_MEMORY_SCOPE_AGENT); } } };
struct SkHgIn { bf16_t* QB; bf16_t* KB; bf16_t* VB; bf16_t* GB; float* LF; const float* LBv; const float* ssq;
    __device__ __forceinline__ int brow(int task, int) const { return 64 * task; }
    __device__ __forceinline__ void operator()(int task, const f32x4 (&acc)[1][4], int c16, int g) const {
        const int sec = task >> 5;
#pragma unroll
        for (int r = 0; r < 4; ++r) { const int R = ROW_META + 4 * g + r; const float rs = row_rs(ssq, R);
#pragma unroll
            for (int nt = 0; nt < 4; ++nt) { const int col = 64 * (task & 31) + 16 * nt + c16; const size_t off = (size_t)R * DM + col; const float x = acc[0][nt][r] * rs;
                if (sec == 0) QB[off] = tobf(x * sigmoidf_(x));
                else if (sec == 1) { const float lb = LBv[col]; const float fg = lb + (1.0f - lb) * sigmoidf_(x); KB[off] = tobf(1.0f - fg); LF[off] = __logf(fg); }
                else if (sec == 2) VB[off] = tobf(x);
                else GB[off] = tobf(sigmoidf_(x)); } } } };
struct SkFoxIn { bf16_t* QB; bf16_t* KB; bf16_t* VB; bf16_t* GB; float* LFX; const float* bfv; const float* ssq;
    __device__ __forceinline__ int brow(int task, int) const { return 64 * task; }
    __device__ __forceinline__ void operator()(int task, const f32x4 (&acc)[1][4], int c16, int g) const {
        const int sec = task >> 5;
#pragma unroll
        for (int r = 0; r < 4; ++r) { const int R = ROW_META + 4 * g + r; const float rs = row_rs(ssq, R);
            if (sec == 4) { const float z = acc[0][0][r] * rs + bfv[c16]; LFX[(size_t)R * 16 + c16] = fminf(z, 0.f) - __logf(1.0f + fexp(-fabsf(z))); }
            else {
#pragma unroll
                for (int nt = 0; nt < 4; ++nt) { const int col = 64 * (task & 31) + 16 * nt + c16; const size_t off = (size_t)R * DM + col; const float x = acc[0][nt][r] * rs;
                    if (sec == 3) GB[off] = tobf(sigmoidf_(x));
                    else if (sec == 0) QB[off] = tobf(x);
                    else if (sec == 1) KB[off] = tobf(x);
                    else VB[off] = tobf(x); } } } } };
struct SkFgate { float* LFX; const float* bfv; const float* ssq;
    __device__ __forceinline__ int brow(int task, int) const { return 64 * task; }
    __device__ __forceinline__ void operator()(int task, const f32x4 (&acc)[1][4], int c16, int g) const {
        const f32x4 bf = *(const f32x4*)(bfv + 4 * g);
#pragma unroll
        for (int nt = 0; nt < 4; ++nt) { const int R = ROW_X + 64 * task + 16 * nt + c16; const float rs = row_rs(ssq, R); f32x4 o;
#pragma unroll
            for (int r = 0; r < 4; ++r) { const float z = acc[0][nt][r] * rs + bf[r]; o[r] = fminf(z, 0.f) - __logf(1.0f + fexp(-fabsf(z))); }
            *(f32x4*)(LFX + (size_t)R * 16 + 4 * g) = o; } } };
__device__ __forceinline__ void zero_pad_rows(unsigned char* ws, bool hg, int G) {
    const u32x4 z = {0u, 0u, 0u, 0u};
    for (int e = blockIdx.x * NTHREADS + threadIdx.x; e < ROW_META * DM / 8; e += G * NTHREADS) {
        *(u32x4*)(ws + WS_QB + (size_t)e * 16) = z; *(u32x4*)(ws + WS_KB + (size_t)e * 16) = z; *(u32x4*)(ws + WS_VB + (size_t)e * 16) = z; *(u32x4*)(ws + WS_GB + (size_t)e * 16) = z;
        if (hg) { *(u32x4*)(ws + WS_LF + (size_t)e * 32) = z; *(u32x4*)(ws + WS_LF + (size_t)e * 32 + 16) = z; } }
}

#define XB_TMO      128
#define XB_XCNT(j)  (256  + 64 * (j))
#define XB_XSUB(j)  (1280 + 64 * (j))
#define XB_XGEN(j)  (2304 + 64 * (j))
#define XB_TOP      3328
#define XB_TOPGEN   3392
#define XCD_BAR_WORDS 3456
#define XB_SPIN_CAP (1u << 18)
__device__ __forceinline__ unsigned xb_ld(unsigned* p)              { return __hip_atomic_load(p, __ATOMIC_RELAXED, __HIP_MEMORY_SCOPE_AGENT); }
__device__ __forceinline__ unsigned xb_add(unsigned* p, unsigned v) { return __hip_atomic_fetch_add(p, v, __ATOMIC_RELAXED, __HIP_MEMORY_SCOPE_AGENT); }
__device__ __forceinline__ unsigned xb_xcc_id() { return (unsigned)__builtin_amdgcn_s_getreg((3 << 11) | 20) & 0xFu; }
#define XB_SPIN(cond, bar) do { unsigned _sp = 0; while (cond) { __builtin_amdgcn_s_sleep(1); \
    if ((++_sp & 255u) == 0u) { if (xb_ld(&(bar)[XB_TMO])) break; if (_sp > XB_SPIN_CAP) { atomicAdd(&(bar)[XB_TMO], 1u); break; } } } } while (0)
struct XcdBarrier { unsigned* bar; unsigned x; volatile LAS unsigned* st; };
__device__ __forceinline__ XcdBarrier xcd_barrier_post(unsigned* bar, volatile LAS unsigned* st) {
    XcdBarrier b; b.bar = bar; b.x = xb_xcc_id(); b.st = st;
    if (threadIdx.x == 0) (void)xb_add(&bar[XB_XCNT(b.x)], 1u);
    return b;
}
__device__ __forceinline__ void xcd_barrier_complete(unsigned* bar, unsigned x, unsigned& nloc, unsigned& nx) {
    const unsigned G = gridDim.x * gridDim.y * gridDim.z;
    unsigned sum, cnt, mine, sp = 0u;
    for (;;) {
        sum = 0u; cnt = 0u; mine = 0u;
#pragma unroll
        for (unsigned j = 0; j < 16; ++j) { const unsigned c = xb_ld(&bar[XB_XCNT(j)]); sum += c; cnt += (c > 0u) ? 1u : 0u; mine = (j == x) ? c : mine; }
        if (sum == G) break;
        __builtin_amdgcn_s_sleep(1);
        if ((++sp & 255u) == 0u) { if (xb_ld(&bar[XB_TMO])) break; if (sp > XB_SPIN_CAP) { atomicAdd(&bar[XB_TMO], 1u); break; } }
    }
    nloc = mine > 0u ? mine : 1u; nx = cnt > 0u ? cnt : 1u;
}
__device__ __forceinline__ void xcd_barrier(const XcdBarrier& b) {
    asm volatile("s_waitcnt vmcnt(0)" ::: "memory");
    __syncthreads();
    if (threadIdx.x == 0) {
        unsigned* bar = b.bar;
        __builtin_amdgcn_s_waitcnt(0);
        unsigned nloc = b.st[0], nx = b.st[1];
        if (nloc == 0u) { xcd_barrier_complete(bar, b.x, nloc, nx); b.st[0] = nloc; b.st[1] = nx; }
        const unsigned old = xb_add(&bar[XB_XSUB(b.x)], 1u);
        const unsigned gen = old / nloc;
        if (old + 1u == (gen + 1u) * nloc) {
            __builtin_amdgcn_fence(__ATOMIC_RELEASE, "agent");
            asm volatile("s_waitcnt vmcnt(0)" ::: "memory");
            const unsigned og = xb_add(&bar[XB_TOP], 1u);
            const unsigned tg = og / nx;
            if (og + 1u == (tg + 1u) * nx) xb_add(&bar[XB_TOPGEN], 1u);
            else XB_SPIN(xb_ld(&bar[XB_TOPGEN]) == tg, bar);
            __builtin_amdgcn_fence(__ATOMIC_ACQUIRE, "agent");
            xb_add(&bar[XB_XGEN(b.x)], 1u);
            asm volatile("s_waitcnt vmcnt(0)" ::: "memory");
        } else {
            XB_SPIN(xb_ld(&bar[XB_XGEN(b.x)]) == gen, bar);
            __builtin_amdgcn_fence(__ATOMIC_ACQUIRE, "agent");
            asm volatile("s_waitcnt vmcnt(0)" ::: "memory");
        }
    }
    __syncthreads();
}
__device__ __forceinline__ void run_gu(const Args& a, LAS unsigned char* lds, int G, int w, int slot, bool meta) {
    unsigned char* ws = a.ws;
    pg8::Gemm g{(const bf16_t*)(ws + WS_HB) + (size_t)ROW_X * DM, (const bf16_t*)(ws + WS_WGU + w * SZ_WGU1), SEQ, 2 * FF, DM}; pg8::StaticOrder S; S.init(SEQ, 2 * FF, G, (int)blockIdx.x);
    EpiSwiGLU E{(bf16_t*)(ws + WS_ACT), (const float*)(ws + WS_SSQ) + (size_t)slot * TR};
    pg8::gemm_phase<EpiSwiGLU>(lds, g, S, E);
    const int nunit = (SEQ / 256) * (2 * FF / 256), first = (G == 256) ? nunit % G : 0;
    if (meta) { SkSwiGLU K{(bf16_t*)(ws + WS_ACT), (const float*)(ws + WS_SSQ) + (size_t)slot * TR}; skinny_phase<2, SkSwiGLU>(lds, (const bf16_t*)(ws + WS_HB) + (size_t)ROW_META * DM, g.Bt, DM, FF / 64, K, G, first); }
    if ((int)blockIdx.x >= first) { const int wid = threadIdx.x >> 6, lane = threadIdx.x & 63; LAS float* scr = (LAS float*)(lds + wid * 16640);
        for (int it = (int)blockIdx.x - first; it < NDEFER_DN; it += G - first)
            transpose_matrix(a.w_dn + (size_t)w * FF * DM, FF, DM, DM, (bf16_t*)(ws + WS_WDN + w * SZ_WDN1), nullptr, 0, it, scr, wid, lane); }
}
__device__ __forceinline__ void run_dn(const Args& a, LAS unsigned char* lds, int G, int w, int slot) {
    unsigned char* ws = a.ws;
    pg8::Gemm g{(const bf16_t*)(ws + WS_ACT) + (size_t)ROW_X * FF, (const bf16_t*)(ws + WS_WDN + w * SZ_WDN1), SEQ, DM, FF}; pg8::StaticOrder S; S.init(SEQ, DM, G, (int)blockIdx.x);
    EpiResid<false> E{(bf16_t*)(ws + WS_HB), (float*)(ws + WS_SSQ) + (size_t)slot * TR, nullptr, 0.5f};
    { SkResid K{(bf16_t*)(ws + WS_HB), (float*)(ws + WS_SSQ) + (size_t)slot * TR, 0.5f}; skinny_phase<1, SkResid>(lds, (const bf16_t*)(ws + WS_ACT) + (size_t)ROW_META * FF, g.Bt, FF, DM / 64, K, G); }
    pg8::gemm_phase<EpiResid<false>>(lds, g, S, E);
}
__device__ __forceinline__ void run_out(const Args& a, LAS unsigned char* lds, int G, size_t woff, int slot, bool meta) {
    unsigned char* ws = a.ws;
    pg8::Gemm g{(const bf16_t*)(ws + WS_OG) + (size_t)ROW_X * DM, (const bf16_t*)(ws + woff), SEQ, DM, DM}; pg8::StaticOrder S; S.init(SEQ, DM, G, (int)blockIdx.x);
    EpiResid<false> E{(bf16_t*)(ws + WS_HB), (float*)(ws + WS_SSQ) + (size_t)slot * TR, nullptr, 1.0f};
    if (meta) { SkResid K{(bf16_t*)(ws + WS_HB), (float*)(ws + WS_SSQ) + (size_t)slot * TR, 1.0f}; skinny_phase<1, SkResid>(lds, (const bf16_t*)(ws + WS_OG) + (size_t)ROW_META * DM, g.Bt, DM, DM / 64, K, G); }
    pg8::gemm_phase<EpiResid<false>>(lds, g, S, E);
}
__global__ void __launch_bounds__(NTHREADS, 2) fwd_megakernel(Args a) {
    extern __shared__ __attribute__((aligned(16))) unsigned char ldsg[];
    LAS unsigned char* lds = (LAS unsigned char*)ldsg;
    cg::grid_group grid = cg::this_grid();
    const int G = gridDim.x;
    unsigned char* ws = a.ws;
#define GRID_SEAM() do { asm volatile("s_waitcnt vmcnt(0) lgkmcnt(0)" ::: "memory"); grid.sync(); \
        if (threadIdx.x < 64) { __builtin_amdgcn_fence(__ATOMIC_ACQUIRE, "agent"); asm volatile("s_waitcnt vmcnt(0)" ::: "memory"); } \
        __syncthreads(); asm volatile("" ::: "memory"); } while (0)
    volatile LAS unsigned* xst = (volatile LAS unsigned*)(lds + LDS_XST);
    if (threadIdx.x < 2) xst[threadIdx.x] = 0u;
    __syncthreads();
    const XcdBarrier xbar = xcd_barrier_post((unsigned*)(ws + WS_CTL), xst);
#define RUN(k, ...) if (EN(k) && a.ph_lo <= (k) && (k) < a.ph_hi) { __VA_ARGS__; if ((k) + 1 < a.ph_hi) { if ((k) == PH_PREP) GRID_SEAM(); else { xcd_barrier(xbar); asm volatile("" ::: "memory"); } } }
    RUN(PH_PREP, phase_prep(a, lds, G))
    RUN(PH_L0_F1, run_gu(a, lds, G, 0, 0, true))
    RUN(PH_L0_F2, run_dn(a, lds, G, 0, 1))
    RUN(PH_HG_IN, {
        pg8::Gemm g{(const bf16_t*)(ws + WS_HB) + (size_t)ROW_X * DM, (const bf16_t*)(ws + WS_WHI), SEQ, HG_N, DM}; pg8::StaticOrder S; S.init(SEQ, HG_N, G, (int)blockIdx.x);
        EpiHgIn E{(bf16_t*)(ws + WS_QB), (bf16_t*)(ws + WS_KB), (bf16_t*)(ws + WS_VB), (bf16_t*)(ws + WS_GB), (float*)(ws + WS_LF), (const float*)(ws + WS_LB), (const float*)(ws + WS_SSQ) + (size_t)1 * TR};
        zero_pad_rows(ws, true, G);
        { SkHgIn K{E.QB, E.KB, E.VB, E.GB, E.LF, E.LBv, E.ssq}; skinny_phase<1, SkHgIn>(lds, (const bf16_t*)(ws + WS_HB) + (size_t)ROW_META * DM, g.Bt, DM, HG_N / 64, K, G); }
        pg8::gemm_phase<EpiHgIn>(lds, g, S, E); })
    RUN(PH_H1, phase_h1(a, lds, G))
    RUN(PH_H2, phase_h2(a, G))
    RUN(PH_H3, phase_h3(a, lds, G))
    RUN(PH_HG_OUT, run_out(a, lds, G, WS_WHO, 2, true))
    RUN(PH_L0_F3, run_gu(a, lds, G, 1, 2, true))
    RUN(PH_L0_F4, run_dn(a, lds, G, 1, 3))
    RUN(PH_L1_F1, run_gu(a, lds, G, 2, 3, true))
    RUN(PH_L1_F2, run_dn(a, lds, G, 2, 4))
    RUN(PH_FX_IN, {
        pg8::Gemm g{(const bf16_t*)(ws + WS_HB) + (size_t)ROW_X * DM, (const bf16_t*)(ws + WS_WFI), SEQ, 8192, DM}; pg8::StaticOrder S; S.init(SEQ, 8192, G, (int)blockIdx.x);
        EpiFoxIn E{(bf16_t*)(ws + WS_QB), (bf16_t*)(ws + WS_KB), (bf16_t*)(ws + WS_VB), (bf16_t*)(ws + WS_GB), (float*)(ws + WS_LFX), a.fox_b_f, (const float*)(ws + WS_SSQ) + (size_t)4 * TR};
        zero_pad_rows(ws, false, G);
        { SkFoxIn K{E.QB, E.KB, E.VB, E.GB, E.LFX, E.bfv, E.ssq}; skinny_phase<1, SkFoxIn>(lds, (const bf16_t*)(ws + WS_HB) + (size_t)ROW_META * DM, g.Bt, DM, 8192 / 64 + 1, K, G); }
        { SkFgate K{E.LFX, E.bfv, E.ssq}; skinny_phase<1, SkFgate>(lds, (const bf16_t*)(ws + WS_WFI) + (size_t)8192 * DM, (const bf16_t*)(ws + WS_HB) + (size_t)ROW_X * DM, DM, SEQ / 64, K, G); }
        pg8::gemm_phase<EpiFoxIn>(lds, g, S, E); })
    RUN(PH_X2, phase_x2(a, G))
    RUN(PH_X3, phase_x3(a, ldsg, G))
    RUN(PH_FX_OUT, run_out(a, lds, G, WS_WFO, 5, false))
    RUN(PH_L1_F3, run_gu(a, lds, G, 3, 5, false))
    RUN(PH_L1_F4, {
        pg8::Gemm g{(const bf16_t*)(ws + WS_ACT) + (size_t)ROW_X * FF, (const bf16_t*)(ws + WS_WDN + 3 * SZ_WDN1), SEQ, DM, FF}; pg8::StaticOrder S; S.init(SEQ, DM, G, (int)blockIdx.x);
        EpiResid<true> E{(bf16_t*)(ws + WS_HB), nullptr, a.out, 0.5f};
        pg8::gemm_phase<EpiResid<true>>(lds, g, S, E); })
#undef RUN
}

#ifndef N_LAUNCH_SPLIT
#define N_LAUNCH_SPLIT 0
#endif
extern "C" void kernel_launch(void* const* d_in, const int* in_sizes, int n_in, void* d_out, int out_size, void* d_ws, size_t ws_size, hipStream_t stream) {
    static int grid = 0;
    if (grid == 0) {
        if (n_in != 14 || ws_size < WS_END) { fprintf(stderr, "kernel_launch: unexpected inputs (n_in %d, ws %zu < %zu)\n", n_in, ws_size, (size_t)WS_END); grid = -1; return; }
        int dev = 0, cus = 0, per_cu = 0;
        (void)hipGetDevice(&dev); (void)hipDeviceGetAttribute(&cus, hipDeviceAttributeMultiprocessorCount, dev);
        if (hipFuncSetAttribute((const void*)fwd_megakernel, hipFuncAttributeMaxDynamicSharedMemorySize, LDS_BYTES) != hipSuccess) { fprintf(stderr, "kernel_launch: hipFuncSetAttribute failed\n"); grid = -1; return; }
        if (hipOccupancyMaxActiveBlocksPerMultiprocessor(&per_cu, (const void*)fwd_megakernel, NTHREADS, LDS_BYTES) != hipSuccess || per_cu < 1) { fprintf(stderr, "kernel_launch: occupancy query says %d\n", per_cu); per_cu = 1; }
        (void)hipGetLastError();
        grid = cus > 0 ? cus : 256;
    }
    if (grid < 0) return;
    (void)hipMemsetAsync((char*)d_ws + WS_CTL, 0, 16384, stream);
    Args a{};
    a.x = (const float*)d_in[0]; a.meta = (const float*)d_in[1]; a.norm_g = (const float*)d_in[2]; a.w_gu = (const float*)d_in[3]; a.w_dn = (const float*)d_in[4];
    a.lb_logits = (const float*)d_in[5]; a.hg_w_in = (const float*)d_in[6]; a.hg_w_out = (const float*)d_in[7]; a.hg_onorm = (const float*)d_in[8]; a.fox_w_in = (const float*)d_in[9];
    a.fox_b_f = (const float*)d_in[10]; a.fox_w_out = (const float*)d_in[11]; a.fox_qnorm = (const float*)d_in[12]; a.fox_knorm = (const float*)d_in[13];
    a.out = (float*)d_out; a.ws = (unsigned char*)d_ws;
#if N_LAUNCH_SPLIT
    for (int ph = 0; ph < NPH; ++ph) { a.ph_lo = ph; a.ph_hi = ph + 1; void* args[] = {&a};
        hipError_t e = hipLaunchCooperativeKernel((const void*)fwd_megakernel, dim3(grid), dim3(NTHREADS), args, LDS_BYTES, stream);
        if (e != hipSuccess) { fprintf(stderr, "cooperative launch failed: %s\n", hipGetErrorString(e)); break; } }
#else
    a.ph_lo = 0; a.ph_hi = NPH; void* args[] = {&a};
    hipError_t e = hipLaunchCooperativeKernel((const void*)fwd_megakernel, dim3(grid), dim3(NTHREADS), args, LDS_BYTES, stream);
    if (e != hipSuccess) fprintf(stderr, "cooperative launch failed: %s (grid %d)\n", hipGetErrorString(e), grid);
#endif
}
```

```cpp
#include <hip/hip_runtime.h>
#include <hip/hip_cooperative_groups.h>
#include <cstdio>
#include <cstdint>
namespace cg = cooperative_groups;

#define LAS __attribute__((address_space(3)))
typedef unsigned short bf16_t;
typedef short bf16x8 __attribute__((ext_vector_type(8)));
typedef short s16x4 __attribute__((ext_vector_type(4)));
typedef float f32x4 __attribute__((ext_vector_type(4)));
typedef float f32x2 __attribute__((ext_vector_type(2)));
typedef float f32x16 __attribute__((ext_vector_type(16)));
typedef unsigned u32x4 __attribute__((ext_vector_type(4)));
typedef unsigned u32x2 __attribute__((ext_vector_type(2)));

constexpr int DM = 2048, SEQ = 16384, NMETA = 16, FF = 5504, NH = 16, HD = 128;
constexpr int TR = 16640;
constexpr int ROW_META = 240, ROW_X = 256;
constexpr int NCHUNK = TR / 128;
constexpr int HG_N = 8192, FX_N = 8448  , FX_NREAL = 8208;
constexpr float RMS_EPS = 1e-6f;
constexpr int NTHREADS = 512, NWAVES = 8;

constexpr size_t al256(size_t x) { return (x + 255) & ~(size_t)255; }
constexpr size_t WS_CTL = 0;
constexpr size_t WS_WGU = 16384;
constexpr size_t SZ_WGU1 = (size_t)2 * FF * DM * 2;
constexpr size_t WS_WDN = WS_WGU + 4 * SZ_WGU1;
constexpr size_t SZ_WDN1 = (size_t)DM * FF * 2;
constexpr size_t WS_WHI = WS_WDN + 4 * SZ_WDN1;
constexpr size_t WS_WHO = WS_WHI + (size_t)HG_N * DM * 2;
constexpr size_t WS_WFI = WS_WHO + (size_t)DM * DM * 2;
constexpr size_t WS_WFO = WS_WFI + (size_t)FX_N * DM * 2;
constexpr size_t WS_H = WS_WFO + (size_t)DM * DM * 2;
constexpr size_t WS_HB = WS_H + (size_t)TR * DM * 4;
constexpr size_t WS_SSQ = WS_HB + (size_t)TR * DM * 2;
constexpr size_t WS_LB = WS_SSQ + al256((size_t)6 * TR * 4);
constexpr size_t WS_U0 = WS_LB + 8192;
constexpr size_t WS_ACT = WS_U0;
constexpr size_t SZ_TB = (size_t)TR * DM * 2;
constexpr size_t WS_QB = WS_U0, WS_KB = WS_QB + SZ_TB, WS_VB = WS_KB + SZ_TB, WS_GB = WS_VB + SZ_TB, WS_OG = WS_GB + SZ_TB;
constexpr size_t WS_LF = WS_OG + SZ_TB;
constexpr size_t WS_UT = WS_LF + (size_t)TR * DM * 4;
constexpr size_t WS_ST = WS_UT + (size_t)NCHUNK * NH * HD * HD * 4;
constexpr size_t WS_DEC = WS_ST + (size_t)NCHUNK * NH * HD * HD * 2;
constexpr size_t WS_LFX = WS_DEC + al256((size_t)NCHUNK * NH * HD * 4);
constexpr size_t WS_LOC = WS_LFX + (size_t)TR * 16 * 4;
constexpr size_t WS_SEG = WS_LOC + (size_t)TR * 16 * 4;
constexpr size_t WS_RK = WS_SEG + al256((size_t)NCHUNK * 16 * 4);
constexpr size_t WS_END = WS_RK + (size_t)TR * 16 * 4;
static_assert(WS_ACT + (size_t)TR * FF * 2 <= WS_END, "act fits in union");
static_assert(WS_END <= (size_t)4 * 2 * 2 * DM * 2 * FF * 4, "workspace exceeds the guaranteed 4x largest tensor");

constexpr int LDS_BYTES = 147456 + 1024;
constexpr int LDS_XST = 147456;

typedef __bf16 bf16x2_t __attribute__((ext_vector_type(2)));
__device__ __forceinline__ unsigned cvtpk(float lo, float hi) { bf16x2_t v = {(__bf16)lo, (__bf16)hi}; return __builtin_bit_cast(unsigned, v); }
__device__ __forceinline__ float bf2f(unsigned short b) { return __uint_as_float(((unsigned)b) << 16); }
__device__ __forceinline__ float bflo(unsigned w) { return __uint_as_float(w << 16); }
__device__ __forceinline__ float bfhi(unsigned w) { return __uint_as_float(w & 0xffff0000u); }
__device__ __forceinline__ bf16x8 pack8(f32x4 a, f32x4 b) { u32x4 w = {cvtpk(a[0], a[1]), cvtpk(a[2], a[3]), cvtpk(b[0], b[1]), cvtpk(b[2], b[3])}; return *reinterpret_cast<bf16x8*>(&w); }
__device__ __forceinline__ float fexp(float x) { return __builtin_amdgcn_exp2f(x * 1.4426950408889634f); }
__device__ __forceinline__ float sigmoidf_(float x) { return __builtin_amdgcn_rcpf(1.0f + fexp(-x)); }
__device__ __forceinline__ float wave_sum(float v) {
#pragma unroll
    for (int o = 1; o < 64; o <<= 1) v += __shfl_xor(v, o);
    return v;
}

namespace pg8 {
constexpr int BM = 256, BK = 64, HALF = 128, HTB = HALF * BK * 2, STAGE_BYTES = 8 * HTB, NXCD = 8, WGM = 8;
__host__ __device__ __forceinline__ int lds_byte(int r, int c) { const int st = (r >> 4) * 2 + (c >> 5), rr = r & 15, cc = c & 31, ob = rr * 64 + cc * 2; return st * 1024 + (ob ^ (((ob >> 9) & 1) << 5)); }
__host__ __device__ __forceinline__ void stage_rc(int b, int& R, int& C) { const int st = b / 1024, sb = b % 1024, swz = sb ^ (((sb >> 9) & 1) << 5); R = (st >> 1) * 16 + swz / 64; C = (st & 1) * 32 + (swz % 64) / 2; }
__host__ __device__ __forceinline__ int perm32(int rho) { const int n = rho >> 4, i = rho & 15; return 8 * (i >> 2) + 4 * n + (i & 3); }
struct Unit { int pm, pn; };
struct Gemm { const bf16_t* A; const bf16_t* Bt; int M, N, K; };
struct StaticOrder {
    int nM, nN, nwg, G, c;
    __device__ void init(int M, int N, int G_, int c_) { nM = M / BM; nN = N / BM; nwg = nM * nN; G = G_; c = c_; }
    __device__ bool next(int i, Unit& u) const {
        const long L = (long)i * G + c; if (L >= nwg) return false;
        int wgid = (int)L; { const int q = nwg / NXCD, r = nwg % NXCD, xcd = wgid % NXCD, off = wgid / NXCD; wgid = (xcd < r ? xcd * (q + 1) : r * (q + 1) + (xcd - r) * q) + off; }
        const int nig = WGM * nN, gid = wgid / nig, fm = gid * WGM, gsz = (nM - fm) < WGM ? (nM - fm) : WGM;
        u.pm = fm + ((wgid % nig) % gsz); u.pn = (wgid % nig) / gsz; return true;
    }
};

template <class Epi>
__device__ __forceinline__ void gemm_phase(LAS unsigned char* lds, const Gemm g, const StaticOrder& S, const Epi& E) {
    const int tid = threadIdx.x, wid = __builtin_amdgcn_readfirstlane(tid >> 6), lane = tid & 63, wr = wid >> 2, wc = wid & 3, fr = lane & 15, fq = lane >> 4;
    const int K = g.K, nt = K / BK;
    unsigned voffA[2], voffB[2];
#pragma unroll
    for (int i = 0; i < 2; ++i) { int R, C; stage_rc(tid * 16 + i * 8192, R, C); const int Rb = Epi::PERM ? ((R & ~31) + perm32(R & 31)) : R;
        voffA[i] = (unsigned)(R * K + C) * 2u; voffB[i] = (unsigned)(Rb * K + C) * 2u; }
    const size_t kstep = (size_t)(BK * 2);
    const size_t hstep = (size_t)HALF * K * 2;
    const size_t tstep = 2 * hstep;
    const unsigned ldsw = (unsigned)wid * 1024u;
    const int aoff = lds_byte(wr * 64 + fr, fq * 8), boff = lds_byte(wc * 32 + fr, fq * 8);
#define PG8_SA(b, h) (((b) * 2 + (h)) * HTB)
#define PG8_SB(b, h) ((4 + (b) * 2 + (h)) * HTB)
#define PG8_STAGE(bufoff, gbase, voff) do { _Pragma("unroll") for (int _i = 0; _i < 2; ++_i) \
        __builtin_amdgcn_global_load_lds((const unsigned*)((const char*)(gbase) + (voff)[_i]), (LAS unsigned*)(lds + (bufoff) + ldsw + _i * 8192), 16, 0, 0); } while (0)
#define PG8_LDA(dst, b, h) do { _Pragma("unroll") for (int m = 0; m < 4; ++m) _Pragma("unroll") for (int k = 0; k < 2; ++k) dst[m][k] = *(const LAS bf16x8*)(lds + PG8_SA(b, h) + aoff + m * 2048 + k * 1024); } while (0)
#define PG8_LDB(dst, b, h) do { _Pragma("unroll") for (int n = 0; n < 2; ++n) _Pragma("unroll") for (int k = 0; k < 2; ++k) dst[n][k] = *(const LAS bf16x8*)(lds + PG8_SB(b, h) + boff + n * 2048 + k * 1024); } while (0)
#define PG8_MMA(ai, bj, At, Bt) do { __builtin_amdgcn_s_setprio(1); _Pragma("unroll") for (int m = 0; m < 4; ++m) _Pragma("unroll") for (int n = 0; n < 2; ++n) _Pragma("unroll") for (int k = 0; k < 2; ++k) \
        acc[ai][bj][m][n] = __builtin_amdgcn_mfma_f32_16x16x32_bf16(Bt[n][k], At[m][k], acc[ai][bj][m][n], 0, 0, 0); __builtin_amdgcn_s_setprio(0); } while (0)
#define PG8_WAIT_V(n) asm volatile("s_waitcnt vmcnt(" #n ")" ::: "memory")
#define PG8_WAIT_L(n) asm volatile("s_waitcnt lgkmcnt(" #n ")" ::: "memory")
#define PG8_BAR __builtin_amdgcn_s_barrier()
#define PG8_SCHED __builtin_amdgcn_sched_barrier(0)
    Unit cur, nxt; int ui = 0;
    if (!S.next(0, cur)) return;
    f32x4 acc[2][2][4][2];
#pragma unroll
    for (int a = 0; a < 2; ++a)
#pragma unroll
        for (int b = 0; b < 2; ++b)
#pragma unroll
            for (int m = 0; m < 4; ++m)
#pragma unroll
                for (int n = 0; n < 2; ++n) acc[a][b][m][n] = (f32x4){0.f, 0.f, 0.f, 0.f};
    bf16x8 At[4][2], B0[2][2], B1[2][2];
    const char* cA = (const char*)g.A + (size_t)cur.pm * tstep; const char* cB = (const char*)g.Bt + (size_t)cur.pn * tstep;
    typename Epi::Pre pre = E.pre(cur, wr, fr);
    PG8_STAGE(PG8_SB(0, 0), cB, voffB); PG8_STAGE(PG8_SA(0, 0), cA, voffA); PG8_STAGE(PG8_SB(0, 1), cB + hstep, voffB); PG8_STAGE(PG8_SA(0, 1), cA + hstep, voffA);
    if (wr == 1) PG8_BAR;
    PG8_WAIT_V(4); PG8_BAR;
    PG8_STAGE(PG8_SB(1, 0), cB + kstep, voffB); PG8_STAGE(PG8_SA(1, 0), cA + kstep, voffA); PG8_STAGE(PG8_SB(1, 1), cB + hstep + kstep, voffB);
    PG8_WAIT_V(6); PG8_BAR;
    for (;;) {
        const bool has_next = S.next(ui + 1, nxt);
        const char* nA = has_next ? (const char*)g.A + (size_t)nxt.pm * tstep : cA; const char* nB = has_next ? (const char*)g.Bt + (size_t)nxt.pn * tstep : cB;
        for (int t = 0; t < nt; t += 2) {
            const bool last = (t == nt - 2);
            const char* a1 = cA + (size_t)(t + 1) * kstep;
            const char* a2 = last ? nA : cA + (size_t)(t + 2) * kstep; const char* b2 = last ? nB : cB + (size_t)(t + 2) * kstep;
            const char* a3 = a2 + kstep; const char* b3 = b2 + kstep;
            PG8_LDB(B0, 0, 0); PG8_SCHED; PG8_LDA(At, 0, 0); PG8_STAGE(PG8_SA(1, 1), a1 + hstep, voffA);
            PG8_WAIT_L(8); PG8_BAR; PG8_WAIT_L(0); PG8_MMA(0, 0, At, B0); PG8_BAR; PG8_SCHED;
            PG8_LDB(B1, 0, 1); PG8_STAGE(PG8_SB(0, 0), b2, voffB);
            PG8_BAR; PG8_WAIT_L(0); PG8_MMA(0, 1, At, B1); PG8_BAR;
            PG8_LDA(At, 0, 1); PG8_STAGE(PG8_SA(0, 0), a2, voffA);
            PG8_BAR; PG8_WAIT_L(0); PG8_MMA(1, 0, At, B0); PG8_BAR; PG8_SCHED;
            PG8_STAGE(PG8_SB(0, 1), b2 + hstep, voffB);
            PG8_WAIT_V(6); PG8_BAR; PG8_MMA(1, 1, At, B1); PG8_BAR;
            PG8_LDB(B0, 1, 0); PG8_SCHED; PG8_LDA(At, 1, 0); PG8_STAGE(PG8_SA(0, 1), a2 + hstep, voffA);
            PG8_WAIT_L(8); PG8_BAR; PG8_WAIT_L(0); PG8_MMA(0, 0, At, B0); PG8_BAR; PG8_SCHED;
            PG8_LDB(B1, 1, 1); PG8_STAGE(PG8_SB(1, 0), b3, voffB);
            PG8_BAR; PG8_WAIT_L(0); PG8_MMA(0, 1, At, B1); PG8_BAR;
            PG8_LDA(At, 1, 1); PG8_STAGE(PG8_SA(1, 0), a3, voffA);
            PG8_BAR; PG8_WAIT_L(0); PG8_MMA(1, 0, At, B0); PG8_BAR; PG8_SCHED;
            PG8_STAGE(PG8_SB(1, 1), b3 + hstep, voffB);
            PG8_WAIT_V(6); PG8_BAR; PG8_MMA(1, 1, At, B1); PG8_BAR;
        }
        E(acc, cur, wr, wc, fr, fq, pre);
        if (!has_next) break;
        pre = E.pre(nxt, wr, fr);
#pragma unroll
        for (int a = 0; a < 2; ++a)
#pragma unroll
            for (int b = 0; b < 2; ++b)
#pragma unroll
                for (int m = 0; m < 4; ++m)
#pragma unroll
                    for (int n = 0; n < 2; ++n) acc[a][b][m][n] = (f32x4){0.f, 0.f, 0.f, 0.f};
        cur = nxt; cA = nA; cB = nB; ++ui;
    }
    PG8_WAIT_V(0);
    if (wr == 0) PG8_BAR;
    PG8_BAR;
#undef PG8_SA
#undef PG8_SB
#undef PG8_STAGE
#undef PG8_LDA
#undef PG8_LDB
#undef PG8_MMA
#undef PG8_WAIT_V
#undef PG8_WAIT_L
#undef PG8_BAR
#undef PG8_SCHED
}
}
using pg8::Unit; using pg8::HALF; using pg8::BM;

__device__ __forceinline__ float row_rs(const float* ssq, int r) { return __builtin_amdgcn_rsqf(ssq[r] * (1.0f / DM) + RMS_EPS); }

struct PreRs { float rs[8]; };
__device__ __forceinline__ PreRs load_rs(const float* ssq, int pm, int wr, int fr) { PreRs p;
#pragma unroll
    for (int ai = 0; ai < 2; ++ai)
#pragma unroll
        for (int m = 0; m < 4; ++m) p.rs[ai * 4 + m] = ssq[ROW_X + pm * BM + ai * HALF + wr * 64 + m * 16 + fr];
    return p; }
struct PreNone {};
struct EpiSwiGLU {
    static constexpr bool PERM = true;
    bf16_t* O; const float* ssq; typedef PreRs Pre;
    __device__ __forceinline__ Pre pre(const Unit& u, int wr, int fr) const { return load_rs(ssq, u.pm, wr, fr); }
    __device__ __forceinline__ void operator()(const f32x4 (&acc)[2][2][4][2], const Unit& u, int wr, int wc, int fr, int fq, const Pre& P) const {
        const int row0 = ROW_X + u.pm * BM + wr * 64 + fr, col0 = u.pn * HALF + wc * 32 + 8 * fq;
#pragma unroll
        for (int ai = 0; ai < 2; ++ai)
#pragma unroll
            for (int m = 0; m < 4; ++m) { const int r = row0 + ai * HALF + m * 16; const float rs = __builtin_amdgcn_rsqf(P.rs[ai * 4 + m] * (1.0f / DM) + RMS_EPS);
                float y[8];
#pragma unroll
                for (int n = 0; n < 2; ++n)
#pragma unroll
                    for (int j = 0; j < 4; ++j) { const float a = acc[ai][0][m][n][j] * rs, b = acc[ai][1][m][n][j] * rs; y[n * 4 + j] = a * b * sigmoidf_(a); }
                u32x4 w; w.x = cvtpk(y[0], y[1]); w.y = cvtpk(y[2], y[3]); w.z = cvtpk(y[4], y[5]); w.w = cvtpk(y[6], y[7]);
                *(u32x4*)(O + (size_t)r * FF + col0) = w; }
    }
};
template <bool FINAL> struct EpiResid {
    static constexpr bool PERM = true;
    bf16_t* HB; float* ssq_out; float* OUT; float alpha; typedef PreNone Pre;
    __device__ __forceinline__ Pre pre(const Unit&, int, int) const { return Pre{}; }
    __device__ __forceinline__ void operator()(const f32x4 (&acc)[2][2][4][2], const Unit& u, int wr, int wc, int fr, int fq, const Pre&) const {
        const int row0 = ROW_X + u.pm * BM + wr * 64 + fr, col0 = u.pn * BM + wc * 32 + 8 * fq;
        u32x4 hv[2][2]; float sprev = 0.f;
#define ER_LOAD(g_, set_) do { const size_t off_ = (size_t)(row0 + ((g_) >> 2) * HALF + ((g_) & 3) * 16) * DM + col0; \
        hv[set_][0] = *(const u32x4*)(HB + off_); hv[set_][1] = *(const u32x4*)(HB + off_ + HALF); } while (0)
        ER_LOAD(0, 0);
#pragma unroll
        for (int g = 0; g < 8; ++g) { const int ai = g >> 2, m = g & 3; const int r = row0 + ai * HALF + m * 16; const size_t off = (size_t)r * DM + col0; float s = 0.f;
            if (g + 1 < 8) ER_LOAD(g + 1, (g + 1) & 1);
#pragma unroll
            for (int bj = 0; bj < 2; ++bj) { const u32x4 w = hv[g & 1][bj];
                const f32x4 h0 = {bflo(w.x), bfhi(w.x), bflo(w.y), bfhi(w.y)}, h1 = {bflo(w.z), bfhi(w.z), bflo(w.w), bfhi(w.w)};
                const f32x4 o0 = h0 + acc[ai][bj][m][0] * alpha, o1 = h1 + acc[ai][bj][m][1] * alpha;
                if (FINAL) { float* op = OUT + (size_t)(r - ROW_X) * DM + col0 + bj * HALF; *(f32x4*)op = o0; *(f32x4*)(op + 4) = o1; }
                else { u32x4 q; q.x = cvtpk(o0[0], o0[1]); q.y = cvtpk(o0[2], o0[3]); q.z = cvtpk(o1[0], o1[1]); q.w = cvtpk(o1[2], o1[3]); *(u32x4*)(HB + off + bj * HALF) = q;
                       s += ((o0[0] * o0[0] + o0[1] * o0[1]) + (o0[2] * o0[2] + o0[3] * o0[3])) + ((o1[0] * o1[0] + o1[1] * o1[1]) + (o1[2] * o1[2] + o1[3] * o1[3])); } }
            if (!FINAL) { if (g > 0) { float t = sprev; t += __shfl_xor(t, 16); t += __shfl_xor(t, 32);
                    if (fq == 0) __hip_atomic_fetch_add(ssq_out + row0 + ((g - 1) >> 2) * HALF + ((g - 1) & 3) * 16, t, __ATOMIC_RELAXED, __HIP_MEMORY_SCOPE_AGENT); }
                sprev = s; } }
#undef ER_LOAD
        if (!FINAL) { float t = sprev; t += __shfl_xor(t, 16); t += __shfl_xor(t, 32);
            if (fq == 0) __hip_atomic_fetch_add(ssq_out + row0 + HALF + 48, t, __ATOMIC_RELAXED, __HIP_MEMORY_SCOPE_AGENT); }
    }
};
struct EpiHgIn {
    static constexpr bool PERM = true;
    bf16_t* QB; bf16_t* KB; bf16_t* VB; bf16_t* GB; float* LF; const float* LBv; const float* ssq; typedef PreRs Pre;
    __device__ __forceinline__ Pre pre(const Unit& u, int wr, int fr) const { return load_rs(ssq, u.pm, wr, fr); }
    __device__ __forceinline__ void operator()(const f32x4 (&acc)[2][2][4][2], const Unit& u, int wr, int wc, int fr, int fq, const Pre& P) const {
        const int sec = u.pn >> 3, row0 = ROW_X + u.pm * BM + wr * 64 + fr, colb = (u.pn & 7) * BM + wc * 32 + 8 * fq;
#pragma unroll
        for (int ai = 0; ai < 2; ++ai)
#pragma unroll
            for (int m = 0; m < 4; ++m) { const int r = row0 + ai * HALF + m * 16; const float rs = __builtin_amdgcn_rsqf(P.rs[ai * 4 + m] * (1.0f / DM) + RMS_EPS);
#pragma unroll
                for (int bj = 0; bj < 2; ++bj) { const int c = colb + bj * HALF; const size_t off = (size_t)r * DM + c; float x[8], y[8];
#pragma unroll
                    for (int n = 0; n < 2; ++n)
#pragma unroll
                        for (int j = 0; j < 4; ++j) x[n * 4 + j] = acc[ai][bj][m][n][j] * rs;
                    bf16_t* dst;
                    if (sec == 0) { dst = QB;
#pragma unroll
                        for (int j = 0; j < 8; ++j) y[j] = x[j] * sigmoidf_(x[j]); }
                    else if (sec == 1) { dst = KB; const f32x4 l0 = *(const f32x4*)(LBv + c), l1 = *(const f32x4*)(LBv + c + 4); float lf[8];
#pragma unroll
                        for (int j = 0; j < 8; ++j) { const float lb = j < 4 ? l0[j] : l1[j - 4]; const float fg = lb + (1.0f - lb) * sigmoidf_(x[j]); y[j] = 1.0f - fg; lf[j] = __logf(fg); }
                        *(f32x4*)(LF + off) = (f32x4){lf[0], lf[1], lf[2], lf[3]}; *(f32x4*)(LF + off + 4) = (f32x4){lf[4], lf[5], lf[6], lf[7]}; }
                    else if (sec == 2) { dst = VB;
#pragma unroll
                        for (int j = 0; j < 8; ++j) y[j] = x[j]; }
                    else { dst = GB;
#pragma unroll
                        for (int j = 0; j < 8; ++j) y[j] = sigmoidf_(x[j]); }
                    u32x4 w; w.x = cvtpk(y[0], y[1]); w.y = cvtpk(y[2], y[3]); w.z = cvtpk(y[4], y[5]); w.w = cvtpk(y[6], y[7]);
                    *(u32x4*)(dst + off) = w; } }
    }
};
struct EpiFoxIn {
    static constexpr bool PERM = true;
    bf16_t* QB; bf16_t* KB; bf16_t* VB; bf16_t* GB; float* LFX; const float* bfv; const float* ssq; typedef PreRs Pre;
    __device__ __forceinline__ Pre pre(const Unit& u, int wr, int fr) const { return load_rs(ssq, u.pm, wr, fr); }
    __device__ __forceinline__ void operator()(const f32x4 (&acc)[2][2][4][2], const Unit& u, int wr, int wc, int fr, int fq, const Pre& P) const {
        const int sec = u.pn >> 3, row0 = ROW_X + u.pm * BM + wr * 64 + fr, colb = (u.pn & 7) * BM + wc * 32 + 8 * fq;
#pragma unroll
        for (int ai = 0; ai < 2; ++ai)
#pragma unroll
            for (int m = 0; m < 4; ++m) { const int r = row0 + ai * HALF + m * 16; const float rs = __builtin_amdgcn_rsqf(P.rs[ai * 4 + m] * (1.0f / DM) + RMS_EPS);
                if (sec == 4) {
                    if (wc == 0 && fq < 2) {
#pragma unroll
                        for (int n = 0; n < 2; ++n) { f32x4 o;
#pragma unroll
                            for (int j = 0; j < 4; ++j) { const float z = acc[ai][0][m][n][j] * rs + bfv[8 * fq + 4 * n + j]; o[j] = fminf(z, 0.f) - __logf(1.0f + fexp(-fabsf(z))); }
                            *(f32x4*)(LFX + (size_t)r * 16 + 8 * fq + 4 * n) = o; } }
                } else {
#pragma unroll
                    for (int bj = 0; bj < 2; ++bj) { const size_t off = (size_t)r * DM + colb + bj * HALF; float y[8];
#pragma unroll
                        for (int n = 0; n < 2; ++n)
#pragma unroll
                            for (int j = 0; j < 4; ++j) { const float x = acc[ai][bj][m][n][j] * rs; y[n * 4 + j] = (sec == 3) ? sigmoidf_(x) : x; }
                        bf16_t* dst = sec == 0 ? QB : sec == 1 ? KB : sec == 2 ? VB : GB;
                        u32x4 w; w.x = cvtpk(y[0], y[1]); w.y = cvtpk(y[2], y[3]); w.z = cvtpk(y[4], y[5]); w.w = cvtpk(y[6], y[7]);
                        *(u32x4*)(dst + off) = w; } } }
    }
};

struct Args {
    const float* x; const float* meta; const float* norm_g; const float* w_gu; const float* w_dn; const float* lb_logits; const float* hg_w_in; const float* hg_w_out;
    const float* hg_onorm; const float* fox_w_in; const float* fox_b_f; const float* fox_w_out; const float* fox_qnorm; const float* fox_knorm;
    float* out; unsigned char* ws; int ph_lo, ph_hi;
};
#ifndef PHMASK
#define PHMASK 0xFFFFFFFFu
#endif
#define EN(p) (((PHMASK) >> (p)) & 1u)
enum { PH_PREP = 0, PH_L0_F1, PH_L0_F2, PH_HG_IN, PH_H1, PH_H2, PH_H3, PH_HG_OUT, PH_L0_F3, PH_L0_F4, PH_L1_F1, PH_L1_F2, PH_FX_IN, PH_X2, PH_X3, PH_FX_OUT, PH_L1_F3, PH_L1_F4, NPH };

__device__ __forceinline__ void transpose_tile64(const float* W, int K, int ldn, bf16_t* WT, const float* gain, int k0, int n0, int drow0, LAS float* scr, int lane) {
    f32x2 v[32];
#pragma unroll
    for (int i = 0; i < 32; ++i) { const int kk = 2 * i + (lane >> 5); v[i] = *(const f32x2*)(W + (size_t)(k0 + kk) * ldn + n0 + 2 * (lane & 31)); }
#pragma unroll
    for (int i = 0; i < 32; ++i) { const int kk = 2 * i + (lane >> 5); const float gs = gain ? gain[k0 + kk] : 1.0f; scr[kk * 65 + 2 * (lane & 31)] = v[i][0] * gs; scr[kk * 65 + 2 * (lane & 31) + 1] = v[i][1] * gs; }
    asm volatile("s_waitcnt lgkmcnt(0)" ::: "memory");
    const int c = lane & 7;
#pragma unroll
    for (int j = 0; j < 8; ++j) { const int n = (lane >> 3) + 8 * j; const LAS float* p = scr + (8 * c) * 65 + n;
        u32x4 o; o.x = cvtpk(p[0 * 65], p[1 * 65]); o.y = cvtpk(p[2 * 65], p[3 * 65]); o.z = cvtpk(p[4 * 65], p[5 * 65]); o.w = cvtpk(p[6 * 65], p[7 * 65]);
        *(u32x4*)(WT + (size_t)(drow0 + n) * K + k0 + 8 * c) = o; }
    asm volatile("s_waitcnt lgkmcnt(0)" ::: "memory");
}
__device__ __forceinline__ void transpose_matrix(const float* W, int K, int N, int ldn, bf16_t* WT, const float* gain, int mode, int bitem, LAS float* scr, int wid, int lane) {
    const int nblk = N / 64, kg = bitem / nblk, nb = bitem % nblk, kbk = kg * 8 + wid;
    if (kbk * 64 >= K) return;
    const int n0 = 64 * nb; int drow0 = n0;
    if (mode == 1) { const int isb = n0 >= FF, f = n0 - isb * FF; drow0 = (f >> 7) * 256 + isb * 128 + (f & 127); }
    transpose_tile64(W, K, ldn, WT, gain, kbk * 64, n0, drow0, scr, lane);
}
__device__ __forceinline__ void phase_prep(const Args& a, LAS unsigned char* lds, int G) {
    const int tid = threadIdx.x, wid = tid >> 6, lane = tid & 63;
    unsigned char* ws = a.ws;
    LAS float* scr = (LAS float*)(lds + wid * 16640);
    const int gw = blockIdx.x * NWAVES + wid, NGW = G * NWAVES;
    constexpr int B_GU = (2 * FF / 64) * (DM / 512), B_DN = (DM / 64) * ((FF / 64 + 7) / 8), B_HI = (HG_N / 64) * (DM / 512), B_O = (DM / 64) * (DM / 512), B_FI = (8192 / 64) * (DM / 512);
    constexpr int NBITEMS = 4 * B_GU + 4 * B_DN + B_HI + B_O + B_FI + B_O;
    for (int it = blockIdx.x; it < NBITEMS; it += G) {
        int r = it;
        if (r < 4 * B_GU) { const int w = r / B_GU; r -= w * B_GU; const int layer = w >> 1, j = w & 1;
            transpose_matrix(a.w_gu + (size_t)w * DM * 2 * FF, DM, 2 * FF, 2 * FF, (bf16_t*)(ws + WS_WGU + w * SZ_WGU1), a.norm_g + (layer * 3 + (j ? 2 : 0)) * DM, 1, r, scr, wid, lane); continue; }
        r -= 4 * B_GU;
        if (r < 4 * B_DN) { const int w = r / B_DN; r -= w * B_DN;
            transpose_matrix(a.w_dn + (size_t)w * FF * DM, FF, DM, DM, (bf16_t*)(ws + WS_WDN + w * SZ_WDN1), nullptr, 0, r, scr, wid, lane); continue; }
        r -= 4 * B_DN;
        if (r < B_HI) { transpose_matrix(a.hg_w_in, DM, HG_N, HG_N, (bf16_t*)(ws + WS_WHI), a.norm_g + (0 * 3 + 1) * DM, 0, r, scr, wid, lane); continue; }
        r -= B_HI;
        if (r < B_O) { transpose_matrix(a.hg_w_out, DM, DM, DM, (bf16_t*)(ws + WS_WHO), nullptr, 0, r, scr, wid, lane); continue; }
        r -= B_O;
        if (r < B_FI) { transpose_matrix(a.fox_w_in, DM, 8192, FX_NREAL, (bf16_t*)(ws + WS_WFI), a.norm_g + (1 * 3 + 1) * DM, 0, r, scr, wid, lane); continue; }
        r -= B_FI;
        transpose_matrix(a.fox_w_out, DM, DM, DM, (bf16_t*)(ws + WS_WFO), nullptr, 0, r, scr, wid, lane);
    }
    { const int gt = blockIdx.x * NTHREADS + tid, NT = G * NTHREADS; bf16_t* WT = (bf16_t*)(ws + WS_WFI); const float* gain = a.norm_g + (1 * 3 + 1) * DM;
      for (int e = gt; e < 256 * DM; e += NT) { const int n = e / DM, k = e % DM; float v = 0.f; if (n < 16) v = a.fox_w_in[(size_t)k * FX_NREAL + 8192 + n] * gain[k];
          WT[(size_t)(8192 + n) * DM + k] = (bf16_t)(cvtpk(v, 0.f) & 0xffffu); }
      for (int e = gt; e < DM; e += NT) { const float l0 = a.lb_logits[e], l1 = a.lb_logits[DM + e], l2 = a.lb_logits[2 * DM + e]; const float mx = fmaxf(l0, fmaxf(l1, l2));
          const float e0 = fexp(l0 - mx), e1 = fexp(l1 - mx), e2 = fexp(l2 - mx); ((float*)(ws + WS_LB))[e] = e0 / (e0 + e1 + e2); }
      float* ssq = (float*)(ws + WS_SSQ);
      for (int e = gt; e < 5 * TR; e += NT) ssq[TR + e] = 0.f;
      }
    bf16_t* HB = (bf16_t*)(ws + WS_HB); float* ssq0 = (float*)(ws + WS_SSQ);
    for (int rg = blockIdx.x; rg < TR / 32; rg += G)
    for (int jr = 0; jr < 4; ++jr) { const int r = rg * 32 + wid * 4 + jr;
        const float* src = r >= ROW_X ? a.x + (size_t)(r - ROW_X) * DM : (r >= ROW_META ? a.meta + (size_t)(r - ROW_META) * DM : nullptr);
        float s = 0.f;
#pragma unroll
        for (int j = 0; j < 8; ++j) { f32x4 v = src ? *(const f32x4*)(src + j * 256 + lane * 4) : (f32x4){0.f, 0.f, 0.f, 0.f};
            u32x2 w; w.x = cvtpk(v[0], v[1]); w.y = cvtpk(v[2], v[3]); *(u32x2*)(HB + (size_t)r * DM + j * 256 + lane * 4) = w;
            s += (v[0] * v[0] + v[1] * v[1]) + (v[2] * v[2] + v[3] * v[3]); }
        s = wave_sum(s); if (lane == 0) ssq0[r] = s;
    }
}

#define TRRD2(d0, d1, a0_, a1_) asm volatile("ds_read_b64_tr_b16 %0, %2\n\tds_read_b64_tr_b16 %1, %3\n\ts_waitcnt lgkmcnt(0)" : "=&v"(d0), "=&v"(d1) : "v"(a0_), "v"(a1_) : "memory")
#define TRRD16(D, b0_, b1_) asm volatile( \
    "ds_read_b64_tr_b16 %0, %16\n\tds_read_b64_tr_b16 %1, %17\n\t" \
    "ds_read_b64_tr_b16 %2, %16 offset:32\n\tds_read_b64_tr_b16 %3, %17 offset:32\n\t" \
    "ds_read_b64_tr_b16 %4, %16 offset:64\n\tds_read_b64_tr_b16 %5, %17 offset:64\n\t" \
    "ds_read_b64_tr_b16 %6, %16 offset:96\n\tds_read_b64_tr_b16 %7, %17 offset:96\n\t" \
    "ds_read_b64_tr_b16 %8, %16 offset:128\n\tds_read_b64_tr_b16 %9, %17 offset:128\n\t" \
    "ds_read_b64_tr_b16 %10, %16 offset:160\n\tds_read_b64_tr_b16 %11, %17 offset:160\n\t" \
    "ds_read_b64_tr_b16 %12, %16 offset:192\n\tds_read_b64_tr_b16 %13, %17 offset:192\n\t" \
    "ds_read_b64_tr_b16 %14, %16 offset:224\n\tds_read_b64_tr_b16 %15, %17 offset:224\n\t" \
    "s_waitcnt lgkmcnt(0)" \
    : "=&v"(D[0]), "=&v"(D[1]), "=&v"(D[2]), "=&v"(D[3]), "=&v"(D[4]), "=&v"(D[5]), "=&v"(D[6]), "=&v"(D[7]), \
      "=&v"(D[8]), "=&v"(D[9]), "=&v"(D[10]), "=&v"(D[11]), "=&v"(D[12]), "=&v"(D[13]), "=&v"(D[14]), "=&v"(D[15]) \
    : "v"(b0_), "v"(b1_) : "memory")
constexpr int VPITCH = 288;
__device__ __forceinline__ bf16x8 join4(s16x4 a, s16x4 b) { return (bf16x8){a[0], a[1], a[2], a[3], b[0], b[1], b[2], b[3]}; }
__device__ __forceinline__ void stage_tile128(const bf16_t* src, LAS unsigned char* dst, int tid) {
#pragma unroll
    for (int k = 0; k < 4; ++k) { const int id = tid + NTHREADS * k, row = id >> 4, cc = id & 15; const u32x4 v = *(const u32x4*)(src + (size_t)row * DM + cc * 8); *(LAS u32x4*)(dst + row * VPITCH + cc * 16) = v; }
}
constexpr int SPITCH = 272;
__device__ __forceinline__ void stage_state(const bf16_t* src, LAS unsigned char* dst, int tid) {
#pragma unroll
    for (int k = 0; k < 4; ++k) { const int id = tid + NTHREADS * k, row = id >> 4, cc = id & 15; const u32x4 v = *(const u32x4*)(src + (size_t)row * HD + cc * 8); *(LAS u32x4*)(dst + row * SPITCH + cc * 16) = v; }
}
__device__ __forceinline__ void phase_h1(const Args& a, LAS unsigned char* lds, int G) {
    const int tid = threadIdx.x, wid = __builtin_amdgcn_readfirstlane(tid >> 6), lane = tid & 63, i16 = lane & 15, g = lane >> 4;
    unsigned char* ws = a.ws; float* LF = (float*)(ws + WS_LF); const bf16_t* KBp = (const bf16_t*)(ws + WS_KB); const bf16_t* VBp = (const bf16_t*)(ws + WS_VB);
    bf16_t* UT = (bf16_t*)(ws + WS_UT); float* DEC = (float*)(ws + WS_DEC);
    LAS unsigned char* Vs = lds; LAS unsigned char* Ks = lds + 128 * VPITCH; LAS float* tot = (LAS float*)(lds + 2 * 128 * VPITCH);
    for (int item = blockIdx.x; item < NCHUNK * NH; item += G) {
        const int c = item / NH, h = item % NH, R0 = c * 128;
        const int d = tid & 127, part = tid >> 7;
        float* lfp = LF + (size_t)(R0 + 32 * part) * DM + h * HD + d; const bf16_t* kp = KBp + (size_t)(R0 + 32 * part) * DM + h * HD + d;
        float bl[32]; float run = 0.f;
#pragma unroll
        for (int i = 0; i < 32; ++i) { run += lfp[(size_t)i * DM]; bl[i] = run; }
        tot[part * 128 + d] = run;
        stage_tile128(VBp + (size_t)R0 * DM + h * HD, Vs, tid);
        __syncthreads();
        const float t0 = tot[d], t1 = tot[128 + d], t2 = tot[256 + d], t3 = tot[384 + d];
        const float off = part == 0 ? 0.f : part == 1 ? t0 : part == 2 ? t0 + t1 : t0 + t1 + t2; const float blast = (t0 + t1) + (t2 + t3);
#pragma unroll
        for (int i = 0; i < 32; ++i) { const float b = bl[i] + off; lfp[(size_t)i * DM] = b; const float kv = bf2f(kp[(size_t)i * DM]) * fexp(blast - b);
            *(LAS bf16_t*)(Ks + (32 * part + i) * VPITCH + d * 2) = (bf16_t)(cvtpk(kv, 0.f) & 0xffffu); }
        if (part == 0) DEC[(size_t)(c * NH + h) * HD + d] = fexp(blast);
        __syncthreads();
        f32x4 acc[8];
#pragma unroll
        for (int n = 0; n < 8; ++n) acc[n] = (f32x4){0.f, 0.f, 0.f, 0.f};
        const int rsel = 4 * g + (i16 >> 2), csel = 4 * (i16 & 3);
#pragma unroll
        for (int ks = 0; ks < 4; ++ks) { const int s0 = 32 * ks;
            s16x4 a0, a1; TRRD2(a0, a1, (unsigned)(uintptr_t)(Vs + (s0 + rsel) * VPITCH + (16 * wid + csel) * 2), (unsigned)(uintptr_t)(Vs + (s0 + 16 + rsel) * VPITCH + (16 * wid + csel) * 2));
            const bf16x8 af = join4(a0, a1);
            s16x4 bd[16]; TRRD16(bd, (unsigned)(uintptr_t)(Ks + (s0 + rsel) * VPITCH + csel * 2), (unsigned)(uintptr_t)(Ks + (s0 + 16 + rsel) * VPITCH + csel * 2));
#pragma unroll
            for (int n = 0; n < 8; ++n) acc[n] = __builtin_amdgcn_mfma_f32_16x16x32_bf16(af, join4(bd[2 * n], bd[2 * n + 1]), acc[n], 0, 0, 0); }
        bf16_t* up = UT + ((size_t)(c * NH + h) * HD + 16 * wid + 4 * g) * HD + i16;
#pragma unroll
        for (int n = 0; n < 8; ++n)
#pragma unroll
            for (int r = 0; r < 4; ++r) up[(size_t)r * HD + 16 * n] = (bf16_t)(cvtpk(acc[n][r], 0.f) & 0xffffu);
        __syncthreads();
    }
}
__device__ __forceinline__ void phase_h2(const Args& a, int G) {
    unsigned char* ws = a.ws; const bf16_t* UT = (const bf16_t*)(ws + WS_UT); const float* DEC = (const float*)(ws + WS_DEC); bf16_t* ST = (bf16_t*)(ws + WS_ST);
    for (int e = blockIdx.x * NTHREADS + threadIdx.x; e < NH * HD * 64; e += G * NTHREADS) {
        const int hv = e >> 6, dp = e & 63, h = hv >> 7, v = hv & 127, d = 2 * dp;
        f32x2 S = {0.f, 0.f};
        for (int c0 = 0; c0 < NCHUNK; c0 += 10) {
            f32x2 u[10], dc[10];
#pragma unroll
            for (int k = 0; k < 10; ++k) { const int c = c0 + k; { const unsigned uw = *(const unsigned*)(UT + ((size_t)(c * NH + h) * HD + v) * HD + d); u[k] = (f32x2){bflo(uw), bfhi(uw)}; } dc[k] = *(const f32x2*)(DEC + (size_t)(c * NH + h) * HD + d); }
#pragma unroll
            for (int k = 0; k < 10; ++k) { const int c = c0 + k; *(unsigned*)(ST + ((size_t)(c * NH + h) * HD + v) * HD + d) = cvtpk(S[0], S[1]); S = dc[k] * S + u[k]; }
        }
    }
}
__device__ __forceinline__ void phase_h3(const Args& a, LAS unsigned char* lds, int G) {
    const int tid = threadIdx.x, wid = __builtin_amdgcn_readfirstlane(tid >> 6), lane = tid & 63, i16 = lane & 15, g = lane >> 4;
    unsigned char* ws = a.ws; const float* Bb = (const float*)(ws + WS_LF); const bf16_t* QBp = (const bf16_t*)(ws + WS_QB); const bf16_t* KBp = (const bf16_t*)(ws + WS_KB);
    const bf16_t* VBp = (const bf16_t*)(ws + WS_VB); const bf16_t* GBp = (const bf16_t*)(ws + WS_GB); const bf16_t* ST = (const bf16_t*)(ws + WS_ST); bf16_t* OG = (bf16_t*)(ws + WS_OG);
    constexpr int NPAIR = (NCHUNK - 2) * NH / 2;
    for (int pw = blockIdx.x; pw < NPAIR + NH; pw += G) {
        const bool metaitem = pw >= NPAIR;
        { const int it0 = metaitem ? NH + (pw - NPAIR) : 2 * NH + 2 * pw; const int c0 = it0 / NH, h0 = it0 % NH;
          stage_tile128(VBp + (size_t)(c0 * 128) * DM + h0 * HD, lds, tid);
          stage_state(ST + (size_t)(c0 * NH + h0) * HD * HD, lds + 2 * 128 * VPITCH, tid);
          if (!metaitem) { const int it1 = it0 + 1, c1 = it1 / NH, h1 = it1 % NH; stage_tile128(VBp + (size_t)(c1 * 128) * DM + h1 * HD, lds + 128 * VPITCH, tid);
              stage_state(ST + (size_t)(c1 * NH + h1) * HD * HD, lds + 2 * 128 * VPITCH + 128 * SPITCH, tid); } }
        __syncthreads();
      for (int half = 0; half < (metaitem ? 1 : 2); ++half) {
        const int item = metaitem ? NH + (pw - NPAIR) : 2 * NH + 2 * pw + half;
        const int c = item / NH, h = item % NH, R0 = c * 128;
        const int I = metaitem ? 7 : (half ? 7 - wid : wid);
        if (metaitem && wid != 7) continue;
        LAS unsigned char* Vs = lds + half * (128 * VPITCH);
        const size_t hb = (size_t)h * HD;
        f32x4 br[4][2];
#pragma unroll
        for (int ks = 0; ks < 4; ++ks) { const float* p = Bb + (size_t)(R0 + 16 * I - 1) * DM + hb + 32 * ks + 8 * g;
            if (I > 0) { br[ks][0] = *(const f32x4*)p; br[ks][1] = *(const f32x4*)(p + 4); } else { br[ks][0] = (f32x4){0.f, 0.f, 0.f, 0.f}; br[ks][1] = br[ks][0]; } }
        bf16x8 qf[4], qh[4];
        { const size_t ro = (size_t)(R0 + 16 * I + i16) * DM + hb + 8 * g;
#pragma unroll
          for (int ks = 0; ks < 4; ++ks) { const u32x4 q8 = *(const u32x4*)(QBp + ro + 32 * ks); const f32x4 b0 = *(const f32x4*)(Bb + ro + 32 * ks), b1 = *(const f32x4*)(Bb + ro + 32 * ks + 4);
              float qv[8] = {bflo(q8.x), bfhi(q8.x), bflo(q8.y), bfhi(q8.y), bflo(q8.z), bfhi(q8.z), bflo(q8.w), bfhi(q8.w)}; float x1[8], x2[8];
#pragma unroll
              for (int j = 0; j < 8; ++j) { const float bt = j < 4 ? b0[j] : b1[j - 4], rf = j < 4 ? br[ks][0][j] : br[ks][1][j - 4]; x1[j] = qv[j] * fexp(bt - rf); x2[j] = qv[j] * fexp(bt); }
              u32x4 w1 = {cvtpk(x1[0], x1[1]), cvtpk(x1[2], x1[3]), cvtpk(x1[4], x1[5]), cvtpk(x1[6], x1[7])}; u32x4 w2 = {cvtpk(x2[0], x2[1]), cvtpk(x2[2], x2[3]), cvtpk(x2[4], x2[5]), cvtpk(x2[6], x2[7])};
              qf[ks] = *reinterpret_cast<bf16x8*>(&w1); qh[ks] = *reinterpret_cast<bf16x8*>(&w2); } }
        f32x4 o[8];
#pragma unroll
        for (int n = 0; n < 8; ++n) o[n] = (f32x4){0.f, 0.f, 0.f, 0.f};
        { const LAS unsigned char* sp = lds + 2 * 128 * VPITCH + half * (128 * SPITCH) + i16 * SPITCH + 16 * g;
#pragma unroll
          for (int ks = 0; ks < 4; ++ks)
#pragma unroll
              for (int n = 0; n < 8; ++n) { const bf16x8 sf = *(const LAS bf16x8*)(sp + (16 * n) * SPITCH + 64 * ks); o[n] = __builtin_amdgcn_mfma_f32_16x16x32_bf16(qh[ks], sf, o[n], 0, 0, 0); } }
        const int rsel = 4 * g + (i16 >> 2), csel = 4 * (i16 & 3);
        u32x2 pA = {0u, 0u};
        for (int J = metaitem ? 7 : 0; J <= I; ++J) {
            f32x4 sacc = {0.f, 0.f, 0.f, 0.f};
            const size_t ro = (size_t)(R0 + 16 * J + i16) * DM + hb + 8 * g;
#pragma unroll
            for (int ks = 0; ks < 4; ++ks) { const u32x4 k8 = *(const u32x4*)(KBp + ro + 32 * ks); const f32x4 b0 = *(const f32x4*)(Bb + ro + 32 * ks), b1 = *(const f32x4*)(Bb + ro + 32 * ks + 4);
                float kv[8] = {bflo(k8.x), bfhi(k8.x), bflo(k8.y), bfhi(k8.y), bflo(k8.z), bfhi(k8.z), bflo(k8.w), bfhi(k8.w)}; float x1[8];
#pragma unroll
                for (int j = 0; j < 8; ++j) { const float bs = j < 4 ? b0[j] : b1[j - 4], rf = j < 4 ? br[ks][0][j] : br[ks][1][j - 4]; x1[j] = kv[j] * fexp(fminf(rf - bs, 80.f)); }
                u32x4 w1 = {cvtpk(x1[0], x1[1]), cvtpk(x1[2], x1[3]), cvtpk(x1[4], x1[5]), cvtpk(x1[6], x1[7])};
                sacc = __builtin_amdgcn_mfma_f32_16x16x32_bf16(*reinterpret_cast<bf16x8*>(&w1), qf[ks], sacc, 0, 0, 0); }
            if (J == I) {
#pragma unroll
                for (int r = 0; r < 4; ++r) if (4 * g + r > i16) sacc[r] = 0.f; }
            u32x2 pk = {cvtpk(sacc[0], sacc[1]), cvtpk(sacc[2], sacc[3])};
            if ((J & 1) == 0 && J < I) { pA = pk; continue; }
            u32x2 pB; int sA, sB;
            if (J & 1) { pB = pk; sA = 16 * (J - 1); sB = 16 * J; } else { pA = pk; pB = (u32x2){0u, 0u}; sA = 16 * J; sB = 16 * J; }
            u32x4 pw = {pA.x, pA.y, pB.x, pB.y}; const bf16x8 pf = *reinterpret_cast<bf16x8*>(&pw);
            s16x4 vd[16]; TRRD16(vd, (unsigned)(uintptr_t)(Vs + (sA + rsel) * VPITCH + csel * 2), (unsigned)(uintptr_t)(Vs + (sB + rsel) * VPITCH + csel * 2));
#pragma unroll
            for (int n = 0; n < 8; ++n) o[n] = __builtin_amdgcn_mfma_f32_16x16x32_bf16(pf, join4(vd[2 * n], vd[2 * n + 1]), o[n], 0, 0, 0);
        }
        float rn[4];
#pragma unroll
        for (int r = 0; r < 4; ++r) { float s = 0.f;
#pragma unroll
            for (int n = 0; n < 8; ++n) s += o[n][r] * o[n][r];
            s += __shfl_xor(s, 1); s += __shfl_xor(s, 2); s += __shfl_xor(s, 4); s += __shfl_xor(s, 8);
            rn[r] = __builtin_amdgcn_rsqf(s * (1.0f / HD) + RMS_EPS); }
#pragma unroll
        for (int n = 0; n < 8; ++n) { const float on = a.hg_onorm[16 * n + i16];
#pragma unroll
            for (int r = 0; r < 4; ++r) { const size_t off = (size_t)(R0 + 16 * I + 4 * g + r) * DM + hb + 16 * n + i16;
                const float val = o[n][r] * rn[r] * on * bf2f(GBp[off]); OG[off] = (bf16_t)(cvtpk(val, 0.f) & 0xffffu); } }
      }
        __syncthreads();
    }
}

__device__ __forceinline__ void phase_x2(const Args& a, int G) {
    const int tid = threadIdx.x, wid = tid >> 6, lane = tid & 63;
    unsigned char* ws = a.ws;
    const float* LFX = (const float*)(ws + WS_LFX); float* LOC = (float*)(ws + WS_LOC); float* SEG = (float*)(ws + WS_SEG);
    const int gw = blockIdx.x * NWAVES + wid, NGW = G * NWAVES;
    if (gw < NCHUNK) {
        const int sg = gw, hh = lane & 15, part = lane >> 4; float v[32]; float run = 0.f;
#pragma unroll
        for (int i = 0; i < 32; ++i) { const int r = sg * 128 + part * 32 + i; const float x = r >= ROW_META ? LFX[(size_t)r * 16 + hh] : 0.f; run += x; v[i] = run; }
        const float t0 = __shfl(run, hh), t1 = __shfl(run, 16 + hh), t2 = __shfl(run, 32 + hh), t3 = __shfl(run, 48 + hh);
        const float off = part == 0 ? 0.f : part == 1 ? t0 : part == 2 ? t0 + t1 : t0 + t1 + t2;
#pragma unroll
        for (int i = 0; i < 32; ++i) LOC[(size_t)(sg * 128 + part * 32 + i) * 16 + hh] = v[i] + off;
        if (part == 0) SEG[sg * 16 + hh] = (t0 + t1) + (t2 + t3);
    }
    bf16_t* KBp = (bf16_t*)(ws + WS_KB);
    for (int r = ROW_META + gw; r < TR; r += NGW) {
#pragma unroll
        for (int p = 0; p < 4; ++p) { bf16_t* ptr = KBp + (size_t)r * DM + p * 512 + lane * 8; const u32x4 w = *(const u32x4*)ptr;
            float x[8] = {bflo(w.x), bfhi(w.x), bflo(w.y), bfhi(w.y), bflo(w.z), bfhi(w.z), bflo(w.w), bfhi(w.w)}; float sk = 0.f;
#pragma unroll
            for (int j = 0; j < 8; ++j) sk += x[j] * x[j];
            sk += __shfl_xor(sk, 1); sk += __shfl_xor(sk, 2); sk += __shfl_xor(sk, 4); sk += __shfl_xor(sk, 8);
            const float rn = __builtin_amdgcn_rsqf(sk * (1.0f / HD) + RMS_EPS); const float* gp = a.fox_knorm + (lane & 15) * 8;
#pragma unroll
            for (int j = 0; j < 8; ++j) x[j] = x[j] * rn * gp[j];
            u32x4 o = {cvtpk(x[0], x[1]), cvtpk(x[2], x[3]), cvtpk(x[4], x[5]), cvtpk(x[6], x[7])}; *(u32x4*)ptr = o; }
    }
}

namespace att {
constexpr float SCALE = 0.08838834764831845f, INV_SCALE = 11.313708498984761f, THR = 8.f;
constexpr int QBLK = 32, KVBLK = 64, QB = 256, SHM_V = KVBLK * HD * 2, SHM_K = KVBLK * HD * 2;
#define KSWZ(row, colB) ((row) * 256 + ((colB) ^ (((row) & 7) << 4)))
#define SBAR() __builtin_amdgcn_sched_barrier(0)
__device__ __forceinline__ int v_st(int k, int c) { const int kk = (k & ~0xC) | ((k & 4) << 1) | ((k & 8) >> 1); return ((kk >> 3) * 4 + (c >> 5)) * 512 + ((kk & 7) * 32 + (c & 31)) * 2; }
__device__ __forceinline__ int v_rd_base(int lane) { return ((lane & 3) << 3) | (((lane >> 2) & 3) << 6) | (((lane >> 4) & 1) << 5) | (((lane >> 5) & 1) << 8); }
constexpr int v_rd_off(int d0, int ks, int half) { return d0 * 512 + ks * 4096 + half * 2048; }
__device__ __forceinline__ int crow(int r, int hi) { return (r & 3) + 8 * (r >> 2) + 4 * hi; }
__device__ __forceinline__ void mask_tile(f32x16& p0, f32x16& p1, int dq, unsigned W) {
    const float NEG = -__builtin_inff();
#pragma unroll
    for (int r = 0; r < 16; ++r) { const int c = (r & 3) + 8 * (r >> 2);
        if ((unsigned)(dq - c) >= W) p0[r] = NEG;
        if ((unsigned)(dq - c - 32) >= W) p1[r] = NEG; }
}
__device__ __forceinline__ void partialSM(f32x16& p0, f32x16& p1, float& m_reg, float& mn, float& alpha) {
    float pmax = p0[0];
#pragma unroll
    for (int r = 1; r < 16; ++r) pmax = fmaxf(pmax, p0[r]);
#pragma unroll
    for (int r = 0; r < 16; ++r) pmax = fmaxf(pmax, p1[r]);
    { auto rr = __builtin_amdgcn_permlane32_swap(__float_as_uint(pmax), __float_as_uint(pmax), false, false); pmax = fmaxf(__uint_as_float(rr[0]), __uint_as_float(rr[1])); }
    constexpr float C2 = 1.4426950408889634f * SCALE;
    if (__builtin_expect(__all((pmax - m_reg) * SCALE <= THR), 1)) { mn = m_reg; alpha = 1.f; }
    else { mn = fmaxf(m_reg, pmax); alpha = __builtin_amdgcn_exp2f((m_reg - mn) * C2); m_reg = mn; }
    const float mnL = -mn * C2;
#pragma unroll
    for (int r = 0; r < 16; ++r) p0[r] = fmaf(p0[r], C2, mnL);
#pragma unroll
    for (int r = 0; r < 16; ++r) p1[r] = fmaf(p1[r], C2, mnL);
#pragma unroll
    for (int r = 0; r < 16; ++r) p0[r] = __builtin_amdgcn_exp2f(p0[r]);
}
__device__ __forceinline__ void finishSM(f32x16& p0, f32x16& p1, float alpha, float& l_reg, bf16x8& pa0, bf16x8& pa1, bf16x8& pa2, bf16x8& pa3) {
#pragma unroll
    for (int r = 0; r < 16; ++r) p1[r] = __builtin_amdgcn_exp2f(p1[r]);
    float ps = 0;
#pragma unroll
    for (int r = 0; r < 16; ++r) ps += p0[r];
#pragma unroll
    for (int r = 0; r < 16; ++r) ps += p1[r];
    { auto rr = __builtin_amdgcn_permlane32_swap(__float_as_uint(ps), __float_as_uint(ps), false, false); ps = __uint_as_float(rr[0]) + __uint_as_float(rr[1]); }
    l_reg = l_reg * alpha + ps;
#define PK4(P, B_, OUT) do { unsigned a0 = cvtpk(P[B_+0], P[B_+1]), a1 = cvtpk(P[B_+2], P[B_+3]); unsigned b0 = cvtpk(P[B_+4], P[B_+5]), b1 = cvtpk(P[B_+6], P[B_+7]); \
        auto r0 = __builtin_amdgcn_permlane32_swap(a0, b0, false, false); auto r1 = __builtin_amdgcn_permlane32_swap(a1, b1, false, false); \
        u32x4 w = {r0[0], r1[0], r0[1], r1[1]}; OUT = *reinterpret_cast<bf16x8*>(&w); } while (0)
    PK4(p0, 0, pa0); PK4(p0, 8, pa1); PK4(p1, 0, pa2); PK4(p1, 8, pa3);
#undef PK4
}
__device__ __forceinline__ void qkt(f32x16& p0, f32x16& p1, const char* Kb, int r32, int hi, const bf16x8* qr) {
    p0 = f32x16{}; p1 = f32x16{};
    const char* kb[4];
#pragma unroll
    for (int dd = 0; dd < 4; ++dd) kb[dd] = Kb + KSWZ(r32, (dd * 16 + hi * 8) * 2);
#pragma unroll
    for (int d0 = 0; d0 < 8; ++d0) { const char* ap = kb[d0 & 3] + (d0 >> 2) * 128;
        bf16x8 b0 = *reinterpret_cast<const bf16x8*>(ap);
        bf16x8 b1 = *reinterpret_cast<const bf16x8*>(ap + 32 * 256);
        p0 = __builtin_amdgcn_mfma_f32_32x32x16_bf16(b0, qr[d0], p0, 0, 0, 0);
        p1 = __builtin_amdgcn_mfma_f32_32x32x16_bf16(b1, qr[d0], p1, 0, 0, 0); }
}
__device__ __forceinline__ void pv_tile(f32x16* o, int vb0, bf16x8 pa0, bf16x8 pa1, bf16x8 pa2, bf16x8 pa3) {
#define TRRDO(dst, off) asm volatile("ds_read_b64_tr_b16 %0, %1 offset:%2" : "=&v"(dst) : "v"(vb0), "i"(off) : "memory")
#define PV_D0(d0) do { s16x4 l0, l1, l2, l3, h0, h1, h2, h3; constexpr int b_ = v_rd_off(d0, 0, 0); \
        TRRDO(l0, b_); TRRDO(h0, b_ + 2048); TRRDO(l1, b_ + 4096); TRRDO(h1, b_ + 6144); TRRDO(l2, b_ + 8192); TRRDO(h2, b_ + 10240); TRRDO(l3, b_ + 12288); TRRDO(h3, b_ + 14336); \
        asm volatile("s_waitcnt lgkmcnt(0)" ::: "memory"); SBAR(); \
        o[d0] = __builtin_amdgcn_mfma_f32_32x32x16_bf16(pa0, (bf16x8){l0[0], l0[1], l0[2], l0[3], h0[0], h0[1], h0[2], h0[3]}, o[d0], 0, 0, 0); \
        o[d0] = __builtin_amdgcn_mfma_f32_32x32x16_bf16(pa1, (bf16x8){l1[0], l1[1], l1[2], l1[3], h1[0], h1[1], h1[2], h1[3]}, o[d0], 0, 0, 0); \
        o[d0] = __builtin_amdgcn_mfma_f32_32x32x16_bf16(pa2, (bf16x8){l2[0], l2[1], l2[2], l2[3], h2[0], h2[1], h2[2], h2[3]}, o[d0], 0, 0, 0); \
        o[d0] = __builtin_amdgcn_mfma_f32_32x32x16_bf16(pa3, (bf16x8){l3[0], l3[1], l3[2], l3[3], h3[0], h3[1], h3[2], h3[3]}, o[d0], 0, 0, 0); } while (0)
    PV_D0(0); PV_D0(1); PV_D0(2); PV_D0(3);
#undef PV_D0
#undef TRRDO
}
}

__device__ __forceinline__ void phase_x3(const Args& a, unsigned char* ldsg, int G) {
    using namespace att;
    const int tid = threadIdx.x, wid = __builtin_amdgcn_readfirstlane(tid >> 6), lane = tid & 63, r32 = lane & 31, hi = lane >> 5;
    unsigned char* ws = a.ws; const bf16_t* QBp = (const bf16_t*)(ws + WS_QB); const bf16_t* KBp = (const bf16_t*)(ws + WS_KB); const bf16_t* VBp = (const bf16_t*)(ws + WS_VB);
    const bf16_t* GBp = (const bf16_t*)(ws + WS_GB); bf16_t* OG = (bf16_t*)(ws + WS_OG); const float* LOC = (const float*)(ws + WS_LOC); const float* SEG = (const float*)(ws + WS_SEG); const float* RKp = (const float*)(ws + WS_RK);
    char* V_lds = (char*)ldsg; char* K_lds = (char*)ldsg + 2 * SHM_V;
    float* wsf = (float*)(ldsg + 2 * SHM_V + 2 * SHM_K) + wid * 64; float* li_l = wsf, * al_l = wsf + 32;
    float* ck_l = (float*)(ldsg + 2 * SHM_V + 2 * SHM_K + 2048);
    float* rk_l = ck_l + 128;
    float* cseg = rk_l + 128;
    int* misc = (int*)(cseg + 136);
    float* g2_l = (float*)(misc + 4);
    if (tid < HD) g2_l[tid] = a.fox_qnorm[tid];
    int ksr[2], ksc[2], vsr[2], vsc[2];
#pragma unroll
    for (int i = 0; i < 2; ++i) { const int q = i * 512 + tid; const int row = q >> 4, cpos = q & 15; ksr[i] = row; ksc[i] = ((cpos ^ (row & 7)) * 8);
        const int st = q >> 5, w = q & 31, kkl = w >> 2, cch = w & 3, kk = (st >> 2) * 8 + kkl, key = (kk & ~0xC) | ((kk & 4) << 1) | ((kk & 8) >> 1); vsr[i] = key; vsc[i] = (st & 3) * 32 + cch * 8; }
    LAS unsigned char* ldsl = (LAS unsigned char*)ldsg;
    const int vbase = (int)(uintptr_t)V_lds + v_rd_base(lane);
    float gq = 0.f, gk = 0.f; for (int i = 0; i < HD; ++i) { gq = fmaxf(gq, fabsf(a.fox_qnorm[i])); gk = fmaxf(gk, fabsf(a.fox_knorm[i])); }
    const float THRESH = 105.0f + 2.0f * (gq * gk * (float)HD * SCALE) + 1.0f;
    const int NITEM = (TR / QB - 1) * NH;
    for (int item = blockIdx.x; item < NITEM; item += G) {
        const int qb = (TR / QB) - 1 - item / NH, h = item % NH, R0 = qb * QB; const size_t hb = (size_t)h * HD;
        __syncthreads();
        if (wid == 0) {
            float run = 0.f;
            for (int s0 = 0; s0 < NCHUNK; s0 += 64) { const int sg = s0 + lane; float v = sg < NCHUNK ? SEG[sg * 16 + h] : 0.f; float x = v;
#pragma unroll
                for (int o = 1; o < 64; o <<= 1) { const float y = __shfl_up(x, o); if (lane >= o) x += y; }
                if (sg < NCHUNK) cseg[sg] = run + x - v; run += __shfl(x, 63); }
        }
        if (tid == 0) misc[0] = 1 << 30;
        __syncthreads();
        const int j_hi = R0 / KVBLK + 4;
        { const int rq = R0 < ROW_META ? ROW_META : R0; const float c0 = cseg[rq >> 7] + LOC[(size_t)rq * 16 + h];
          if (tid >= 3 && tid < j_hi) { const int e = tid * KVBLK + 63; const float ce = cseg[e >> 7] + LOC[(size_t)e * 16 + h]; if (c0 - ce >= -THRESH) atomicMin(misc, tid); } }
        __syncthreads();
        const int j_lo = misc[0], NT = j_hi - j_lo;
        const int row = R0 + wid * QBLK + r32;
        bf16x8 qr[8];
        { float sq = 0.f;
#pragma unroll
          for (int d0 = 0; d0 < 8; ++d0) { const u32x4 w = *(const u32x4*)(QBp + (size_t)row * DM + hb + d0 * 16 + hi * 8);
              const float x[8] = {bflo(w.x), bfhi(w.x), bflo(w.y), bfhi(w.y), bflo(w.z), bfhi(w.z), bflo(w.w), bfhi(w.w)};
#pragma unroll
              for (int j = 0; j < 8; ++j) sq += x[j] * x[j]; }
          { auto rr = __builtin_amdgcn_permlane32_swap(__float_as_uint(sq), __float_as_uint(sq), false, false); sq = __uint_as_float(rr[0]) + __uint_as_float(rr[1]); }
          const float rq = __builtin_amdgcn_rsqf(sq * (1.0f / HD) + RMS_EPS);
          asm volatile("" ::: "memory");
#pragma unroll
          for (int d0 = 0; d0 < 8; ++d0) { const u32x4 w = *(const u32x4*)(QBp + (size_t)row * DM + hb + d0 * 16 + hi * 8);
              const f32x4 g0 = *(const f32x4*)(g2_l + d0 * 16 + hi * 8), g1 = *(const f32x4*)(g2_l + d0 * 16 + hi * 8 + 4);
              const f32x4 x0 = {bflo(w.x), bfhi(w.x), bflo(w.y), bfhi(w.y)}, x1 = {bflo(w.z), bfhi(w.z), bflo(w.w), bfhi(w.w)};
              qr[d0] = pack8(x0 * rq * g0, x1 * rq * g1); } }
        const int qlo = R0 + wid * QBLK, qm = row - 4 * hi;
        const unsigned Wm = row >= ROW_META ? (unsigned)(row - (ROW_META - 1)) : 1u;
        float m_reg = -1e30f, l_reg = 0.f; f32x16 o[4] = {};
        float st_c = 0.f;
#define KDMA(kb_, bf) do { _Pragma("unroll") for (int i_ = 0; i_ < 2; ++i_) \
        __builtin_amdgcn_global_load_lds((const unsigned*)(KBp + (size_t)((kb_) + ksr[i_]) * DM + hb + ksc[i_]), (LAS unsigned*)(ldsl + 2 * SHM_V + (bf) * SHM_K + (i_ * 512 + wid * 64) * 16), 16, 0, 0); } while (0)
#define VDMA(kb_, bf) do { _Pragma("unroll") for (int i_ = 0; i_ < 2; ++i_) \
        __builtin_amdgcn_global_load_lds((const unsigned*)(VBp + (size_t)((kb_) + vsr[i_]) * DM + hb + vsc[i_]), (LAS unsigned*)(ldsl + (bf) * SHM_V + (i_ * 512 + wid * 64) * 16), 16, 0, 0); } while (0)
#define CLOAD(kb_) do { if (tid < 64) { st_c = (cseg[((kb_) + tid) >> 7] + LOC[(size_t)((kb_) + tid) * 16 + h]) * INV_SCALE; } } while (0)
#define CWRITE(bf) do { if (tid < 64) { ck_l[(bf) * 64 + tid] = st_c; } } while (0)
#define BIASMASK(P0, P1, t_, bf) do { const int kb_ = (j_lo + (t_)) * KVBLK; const float* ckb = ck_l + (bf) * 64 + 4 * hi; \
        _Pragma("unroll") for (int gI = 0; gI < 4; ++gI) { { const f32x4 c0 = *(const f32x4*)(ckb + 8 * gI); \
            _Pragma("unroll") for (int j = 0; j < 4; ++j) P0[4 * gI + j] -= c0[j]; } SBAR(); \
            { const f32x4 c1 = *(const f32x4*)(ckb + 32 + 8 * gI); \
            _Pragma("unroll") for (int j = 0; j < 4; ++j) P1[4 * gI + j] -= c1[j]; } SBAR(); } \
        if (kb_ + KVBLK - 1 > qlo || kb_ < ROW_META) mask_tile(P0, P1, qm - kb_, Wm); } while (0)
        KDMA(j_lo * KVBLK, 0); VDMA(j_lo * KVBLK, 0); CLOAD(j_lo * KVBLK); CWRITE(0);
        if (NT > 1) { KDMA((j_lo + 1) * KVBLK, 1); CLOAD((j_lo + 1) * KVBLK); CWRITE(1); }
        asm volatile("s_waitcnt vmcnt(0)" ::: "memory");
        __syncthreads();
        f32x16 pA0, pA1, pB0, pB1;
        qkt(pA0, pA1, K_lds, r32, hi, qr); BIASMASK(pA0, pA1, 0, 0);
        __syncthreads();
#define STEP(X0, X1, Y0, Y1, t_, par) do { \
        if ((t_) + 2 < NT) { KDMA((j_lo + (t_) + 2) * KVBLK, par); CLOAD((j_lo + (t_) + 2) * KVBLK); } \
        if ((t_) + 1 < NT) { VDMA((j_lo + (t_) + 1) * KVBLK, (par) ^ 1); qkt(Y0, Y1, K_lds + ((par) ^ 1) * SHM_K, r32, hi, qr); } \
        float mn, alpha; bf16x8 pa0, pa1, pa2, pa3; \
        partialSM(X0, X1, m_reg, mn, alpha); \
        if (__any(alpha < 1.f)) { if (hi == 0) al_l[r32] = alpha; asm volatile("s_waitcnt lgkmcnt(0)" ::: "memory"); \
            _Pragma("unroll") for (int d_ = 0; d_ < 4; ++d_) _Pragma("unroll") for (int r = 0; r < 16; ++r) o[d_][r] *= al_l[crow(r, hi)]; } \
        finishSM(X0, X1, alpha, l_reg, pa0, pa1, pa2, pa3); \
        pv_tile(o, vbase + (par) * SHM_V, pa0, pa1, pa2, pa3); \
        if ((t_) + 1 < NT) BIASMASK(Y0, Y1, (t_) + 1, (par) ^ 1); \
        if ((t_) + 2 < NT) CWRITE(par); \
        asm volatile("s_waitcnt vmcnt(0)" ::: "memory"); \
        __syncthreads(); } while (0)
        for (int t = 0; t < NT; t += 2) {
            STEP(pA0, pA1, pB0, pB1, t, 0);
            if (t + 1 < NT) STEP(pB0, pB1, pA0, pA1, t + 1, 1);
        }
#undef STEP
#undef BIASMASK
#undef KDMA
#undef VDMA
#undef CLOAD
#undef CWRITE
        if (hi == 0) li_l[r32] = l_reg; asm volatile("s_waitcnt lgkmcnt(0)" ::: "memory");
#pragma unroll
        for (int r = 0; r < 16; ++r) { const int orow = crow(r, hi); const float rli = __builtin_amdgcn_rcpf(li_l[orow]); const int grow = R0 + wid * QBLK + orow; const size_t off = (size_t)grow * DM + hb;
#pragma unroll
            for (int d0 = 0; d0 < 4; ++d0) { float v = o[d0][r] * rli * bf2f(GBp[off + d0 * 32 + r32]); if (grow < ROW_META) v = 0.f;
                const float vn = __shfl_xor(v, 1);
                if ((r32 & 1) == 0) *(unsigned*)(OG + off + d0 * 32 + r32) = cvtpk(v, vn); } }
    }
}


__device__ __forceinline__ bf16_t tobf(float v) { return (bf16_t)(cvtpk(v, 0.f) & 0xffffu); }
template <int NG, class Epi>
__device__ __forceinline__ void skinny_phase(LAS unsigned char* lds, const bf16_t* A16, const bf16_t* Bt, int K, int ntask, const Epi& E, int G, int first = 0) {
    const int tid = threadIdx.x, wid = __builtin_amdgcn_readfirstlane(tid >> 6), lane = tid & 63, c16 = lane & 15, g = lane >> 4;
    LAS f32x4* red = (LAS f32x4*)lds;
    const int nks = K / 32;
    if ((int)blockIdx.x < first) return;
    for (int task = blockIdx.x - first; task < ntask; task += G - first) {
        f32x4 acc[NG][4];
        const bf16_t* ap = A16 + (size_t)c16 * K + 8 * g; const bf16_t* bp[NG];
#pragma unroll
        for (int ng = 0; ng < NG; ++ng) { bp[ng] = Bt + (size_t)(E.brow(task, ng) + c16) * K + 8 * g;
#pragma unroll
            for (int nt = 0; nt < 4; ++nt) acc[ng][nt] = (f32x4){0.f, 0.f, 0.f, 0.f}; }
#pragma unroll 8
        for (int ks = wid; ks < nks; ks += 8) { const bf16x8 av = *(const bf16x8*)(ap + 32 * ks);
#pragma unroll
            for (int ng = 0; ng < NG; ++ng)
#pragma unroll
                for (int nt = 0; nt < 4; ++nt) { const bf16x8 bv = *(const bf16x8*)(bp[ng] + (size_t)(16 * nt) * K + 32 * ks); acc[ng][nt] = __builtin_amdgcn_mfma_f32_16x16x32_bf16(av, bv, acc[ng][nt], 0, 0, 0); } }
#pragma unroll
        for (int ng = 0; ng < NG; ++ng)
#pragma unroll
            for (int nt = 0; nt < 4; ++nt) red[((ng * 4 + nt) * 8 + wid) * 64 + lane] = acc[ng][nt];
        __syncthreads();
        if (wid == 0) {
#pragma unroll
            for (int ng = 0; ng < NG; ++ng)
#pragma unroll
                for (int nt = 0; nt < 4; ++nt) { f32x4 t = red[((ng * 4 + nt) * 8) * 64 + lane];
#pragma unroll
                    for (int w = 1; w < 8; ++w) t += red[((ng * 4 + nt) * 8 + w) * 64 + lane];
                    acc[ng][nt] = t; }
            E(task, acc, c16, g); }
        __syncthreads();
    }
}
struct SkSwiGLU { bf16_t* O; const float* ssq;
    __device__ __forceinline__ int brow(int task, int ng) const { const int f0 = 64 * task; return (f0 >> 7) * 256 + (f0 & 127) + ng * 128; }
    __device__ __forceinline__ void operator()(int task, const f32x4 (&acc)[2][4], int c16, int g) const {
#pragma unroll
        for (int r = 0; r < 4; ++r) { const int R = ROW_META + 4 * g + r; const float rs = row_rs(ssq, R);
#pragma unroll
            for (int nt = 0; nt < 4; ++nt) { const float a = acc[0][nt][r] * rs, b = acc[1][nt][r] * rs; O[(size_t)R * FF + 64 * task + 16 * nt + c16] = tobf(a * b * sigmoidf_(a)); } } } };
struct SkResid { bf16_t* HB; float* ssq_out; float alpha;
    __device__ __forceinline__ int brow(int task, int) const { return 64 * task; }
    __device__ __forceinline__ void operator()(int task, const f32x4 (&acc)[1][4], int c16, int g) const {
#pragma unroll
        for (int r = 0; r < 4; ++r) { const int R = ROW_META + 4 * g + r; float s = 0.f;
#pragma unroll
            for (int nt = 0; nt < 4; ++nt) { const size_t off = (size_t)R * DM + 64 * task + 16 * nt + c16; const float o = bf2f(HB[off]) + alpha * acc[0][nt][r]; HB[off] = tobf(o); s += o * o; }
            s += __shfl_xor(s, 1); s += __shfl_xor(s, 2); s += __shfl_xor(s, 4); s += __shfl_xor(s, 8);
            if (c16 == 0) __hip_atomic_fetch_add(ssq_out + R, s, __ATOMIC_RELAXED, __HIP_MEMORY_SCOPE_AGENT); } } };
struct SkHgIn { bf16_t* QB; bf16_t* KB; bf16_t* VB; bf16_t* GB; float* LF; const float* LBv; const float* ssq;
    __device__ __forceinline__ int brow(int task, int) const { return 64 * task; }
    __device__ __forceinline__ void operator()(int task, const f32x4 (&acc)[1][4], int c16, int g) const {
        const int sec = task >> 5;
#pragma unroll
        for (int r = 0; r < 4; ++r) { const int R = ROW_META + 4 * g + r; const float rs = row_rs(ssq, R);
#pragma unroll
            for (int nt = 0; nt < 4; ++nt) { const int col = 64 * (task & 31) + 16 * nt + c16; const size_t off = (size_t)R * DM + col; const float x = acc[0][nt][r] * rs;
                if (sec == 0) QB[off] = tobf(x * sigmoidf_(x));
                else if (sec == 1) { const float lb = LBv[col]; const float fg = lb + (1.0f - lb) * sigmoidf_(x); KB[off] = tobf(1.0f - fg); LF[off] = __logf(fg); }
                else if (sec == 2) VB[off] = tobf(x);
                else GB[off] = tobf(sigmoidf_(x)); } } } };
struct SkFoxIn { bf16_t* QB; bf16_t* KB; bf16_t* VB; bf16_t* GB; float* LFX; const float* bfv; const float* ssq;
    __device__ __forceinline__ int brow(int task, int) const { return 64 * task; }
    __device__ __forceinline__ void operator()(int task, const f32x4 (&acc)[1][4], int c16, int g) const {
        const int sec = task >> 5;
#pragma unroll
        for (int r = 0; r < 4; ++r) { const int R = ROW_META + 4 * g + r; const float rs = row_rs(ssq, R);
            if (sec == 4) { const float z = acc[0][0][r] * rs + bfv[c16]; LFX[(size_t)R * 16 + c16] = fminf(z, 0.f) - __logf(1.0f + fexp(-fabsf(z))); }
            else {
#pragma unroll
                for (int nt = 0; nt < 4; ++nt) { const int col = 64 * (task & 31) + 16 * nt + c16; const size_t off = (size_t)R * DM + col; const float x = acc[0][nt][r] * rs;
                    if (sec == 3) GB[off] = tobf(sigmoidf_(x));
                    else if (sec == 0) QB[off] = tobf(x);
                    else if (sec == 1) KB[off] = tobf(x);
                    else VB[off] = tobf(x); } } } } };
struct SkFgate { float* LFX; const float* bfv; const float* ssq;
    __device__ __forceinline__ int brow(int task, int) const { return 64 * task; }
    __device__ __forceinline__ void operator()(int task, const f32x4 (&acc)[1][4], int c16, int g) const {
        const f32x4 bf = *(const f32x4*)(bfv + 4 * g);
#pragma unroll
        for (int nt = 0; nt < 4; ++nt) { const int R = ROW_X + 64 * task + 16 * nt + c16; const float rs = row_rs(ssq, R); f32x4 o;
#pragma unroll
            for (int r = 0; r < 4; ++r) { const float z = acc[0][nt][r] * rs + bf[r]; o[r] = fminf(z, 0.f) - __logf(1.0f + fexp(-fabsf(z))); }
            *(f32x4*)(LFX + (size_t)R * 16 + 4 * g) = o; } } };
__device__ __forceinline__ void zero_pad_rows(unsigned char* ws, bool hg, int G) {
    const u32x4 z = {0u, 0u, 0u, 0u};
    for (int e = blockIdx.x * NTHREADS + threadIdx.x; e < ROW_META * DM / 8; e += G * NTHREADS) {
        *(u32x4*)(ws + WS_QB + (size_t)e * 16) = z; *(u32x4*)(ws + WS_KB + (size_t)e * 16) = z; *(u32x4*)(ws + WS_VB + (size_t)e * 16) = z; *(u32x4*)(ws + WS_GB + (size_t)e * 16) = z;
        if (hg) { *(u32x4*)(ws + WS_LF + (size_t)e * 32) = z; *(u32x4*)(ws + WS_LF + (size_t)e * 32 + 16) = z; } }
}

#define XB_TMO      128
#define XB_XCNT(j)  (256  + 64 * (j))
#define XB_XSUB(j)  (1280 + 64 * (j))
#define XB_XGEN(j)  (2304 + 64 * (j))
#define XB_TOP      3328
#define XB_TOPGEN   3392
#define XCD_BAR_WORDS 3456
#define XB_SPIN_CAP (1u << 18)
__device__ __forceinline__ unsigned xb_ld(unsigned* p)              { return __hip_atomic_load(p, __ATOMIC_RELAXED, __HIP_MEMORY_SCOPE_AGENT); }
__device__ __forceinline__ unsigned xb_add(unsigned* p, unsigned v) { return __hip_atomic_fetch_add(p, v, __ATOMIC_RELAXED, __HIP_MEMORY_SCOPE_AGENT); }
__device__ __forceinline__ unsigned xb_xcc_id() { return (unsigned)__builtin_amdgcn_s_getreg((3 << 11) | 20) & 0xFu; }
#define XB_SPIN(cond, bar) do { unsigned _sp = 0; while (cond) { __builtin_amdgcn_s_sleep(1); \
    if ((++_sp & 255u) == 0u) { if (xb_ld(&(bar)[XB_TMO])) break; if (_sp > XB_SPIN_CAP) { atomicAdd(&(bar)[XB_TMO], 1u); break; } } } } while (0)
struct XcdBarrier { unsigned* bar; unsigned x; volatile LAS unsigned* st; };
__device__ __forceinline__ XcdBarrier xcd_barrier_post(unsigned* bar, volatile LAS unsigned* st) {
    XcdBarrier b; b.bar = bar; b.x = xb_xcc_id(); b.st = st;
    if (threadIdx.x == 0) (void)xb_add(&bar[XB_XCNT(b.x)], 1u);
    return b;
}
__device__ __forceinline__ void xcd_barrier_complete(unsigned* bar, unsigned x, unsigned& nloc, unsigned& nx) {
    const unsigned G = gridDim.x * gridDim.y * gridDim.z;
    unsigned sum, cnt, mine, sp = 0u;
    for (;;) {
        sum = 0u; cnt = 0u; mine = 0u;
#pragma unroll
        for (unsigned j = 0; j < 16; ++j) { const unsigned c = xb_ld(&bar[XB_XCNT(j)]); sum += c; cnt += (c > 0u) ? 1u : 0u; mine = (j == x) ? c : mine; }
        if (sum == G) break;
        __builtin_amdgcn_s_sleep(1);
        if ((++sp & 255u) == 0u) { if (xb_ld(&bar[XB_TMO])) break; if (sp > XB_SPIN_CAP) { atomicAdd(&bar[XB_TMO], 1u); break; } }
    }
    nloc = mine > 0u ? mine : 1u; nx = cnt > 0u ? cnt : 1u;
}
__device__ __forceinline__ void xcd_barrier(const XcdBarrier& b) {
    asm volatile("s_waitcnt vmcnt(0)" ::: "memory");
    __syncthreads();
    if (threadIdx.x == 0) {
        unsigned* bar = b.bar;
        __builtin_amdgcn_s_waitcnt(0);
        unsigned nloc = b.st[0], nx = b.st[1];
        if (nloc == 0u) { xcd_barrier_complete(bar, b.x, nloc, nx); b.st[0] = nloc; b.st[1] = nx; }
        const unsigned old = xb_add(&bar[XB_XSUB(b.x)], 1u);
        const unsigned gen = old / nloc;
        if (old + 1u == (gen + 1u) * nloc) {
            __builtin_amdgcn_fence(__ATOMIC_RELEASE, "agent");
            asm volatile("s_waitcnt vmcnt(0)" ::: "memory");
            const unsigned og = xb_add(&bar[XB_TOP], 1u);
            const unsigned tg = og / nx;
            if (og + 1u == (tg + 1u) * nx) xb_add(&bar[XB_TOPGEN], 1u);
            else XB_SPIN(xb_ld(&bar[XB_TOPGEN]) == tg, bar);
            __builtin_amdgcn_fence(__ATOMIC_ACQUIRE, "agent");
            xb_add(&bar[XB_XGEN(b.x)], 1u);
            asm volatile("s_waitcnt vmcnt(0)" ::: "memory");
        } else {
            XB_SPIN(xb_ld(&bar[XB_XGEN(b.x)]) == gen, bar);
            __builtin_amdgcn_fence(__ATOMIC_ACQUIRE, "agent");
            asm volatile("s_waitcnt vmcnt(0)" ::: "memory");
        }
    }
    __syncthreads();
}
__device__ __forceinline__ void run_gu(const Args& a, LAS unsigned char* lds, int G, int w, int slot, bool meta) {
    unsigned char* ws = a.ws;
    pg8::Gemm g{(const bf16_t*)(ws + WS_HB) + (size_t)ROW_X * DM, (const bf16_t*)(ws + WS_WGU + w * SZ_WGU1), SEQ, 2 * FF, DM}; pg8::StaticOrder S; S.init(SEQ, 2 * FF, G, (int)blockIdx.x);
    EpiSwiGLU E{(bf16_t*)(ws + WS_ACT), (const float*)(ws + WS_SSQ) + (size_t)slot * TR};
    pg8::gemm_phase<EpiSwiGLU>(lds, g, S, E);
    if (meta) { const int nunit = (SEQ / 256) * (2 * FF / 256), first = (G == 256) ? nunit % G : 0;
        SkSwiGLU K{(bf16_t*)(ws + WS_ACT), (const float*)(ws + WS_SSQ) + (size_t)slot * TR}; skinny_phase<2, SkSwiGLU>(lds, (const bf16_t*)(ws + WS_HB) + (size_t)ROW_META * DM, g.Bt, DM, FF / 64, K, G, first); }
}
__device__ __forceinline__ void run_dn(const Args& a, LAS unsigned char* lds, int G, int w, int slot) {
    unsigned char* ws = a.ws;
    pg8::Gemm g{(const bf16_t*)(ws + WS_ACT) + (size_t)ROW_X * FF, (const bf16_t*)(ws + WS_WDN + w * SZ_WDN1), SEQ, DM, FF}; pg8::StaticOrder S; S.init(SEQ, DM, G, (int)blockIdx.x);
    EpiResid<false> E{(bf16_t*)(ws + WS_HB), (float*)(ws + WS_SSQ) + (size_t)slot * TR, nullptr, 0.5f};
    { SkResid K{(bf16_t*)(ws + WS_HB), (float*)(ws + WS_SSQ) + (size_t)slot * TR, 0.5f}; skinny_phase<1, SkResid>(lds, (const bf16_t*)(ws + WS_ACT) + (size_t)ROW_META * FF, g.Bt, FF, DM / 64, K, G); }
    pg8::gemm_phase<EpiResid<false>>(lds, g, S, E);
}
__device__ __forceinline__ void run_out(const Args& a, LAS unsigned char* lds, int G, size_t woff, int slot, bool meta) {
    unsigned char* ws = a.ws;
    pg8::Gemm g{(const bf16_t*)(ws + WS_OG) + (size_t)ROW_X * DM, (const bf16_t*)(ws + woff), SEQ, DM, DM}; pg8::StaticOrder S; S.init(SEQ, DM, G, (int)blockIdx.x);
    EpiResid<false> E{(bf16_t*)(ws + WS_HB), (float*)(ws + WS_SSQ) + (size_t)slot * TR, nullptr, 1.0f};
    if (meta) { SkResid K{(bf16_t*)(ws + WS_HB), (float*)(ws + WS_SSQ) + (size_t)slot * TR, 1.0f}; skinny_phase<1, SkResid>(lds, (const bf16_t*)(ws + WS_OG) + (size_t)ROW_META * DM, g.Bt, DM, DM / 64, K, G); }
    pg8::gemm_phase<EpiResid<false>>(lds, g, S, E);
}
__global__ void __launch_bounds__(NTHREADS, 2) fwd_megakernel(Args a) {
    extern __shared__ __attribute__((aligned(16))) unsigned char ldsg[];
    LAS unsigned char* lds = (LAS unsigned char*)ldsg;
    cg::grid_group grid = cg::this_grid();
    const int G = gridDim.x;
    unsigned char* ws = a.ws;
#define GRID_SEAM() do { asm volatile("s_waitcnt vmcnt(0) lgkmcnt(0)" ::: "memory"); grid.sync(); \
        if (threadIdx.x < 64) { __builtin_amdgcn_fence(__ATOMIC_ACQUIRE, "agent"); asm volatile("s_waitcnt vmcnt(0)" ::: "memory"); } \
        __syncthreads(); asm volatile("" ::: "memory"); } while (0)
    volatile LAS unsigned* xst = (volatile LAS unsigned*)(lds + LDS_XST);
    if (threadIdx.x < 2) xst[threadIdx.x] = 0u;
    __syncthreads();
    const XcdBarrier xbar = xcd_barrier_post((unsigned*)(ws + WS_CTL), xst);
    if (a.ph_lo < 0) GRID_SEAM();
#define RUN(k, ...) if (EN(k) && a.ph_lo <= (k) && (k) < a.ph_hi) { __VA_ARGS__; if ((k) + 1 < a.ph_hi) { xcd_barrier(xbar); asm volatile("" ::: "memory"); } }
    RUN(PH_PREP, phase_prep(a, lds, G))
    RUN(PH_L0_F1, run_gu(a, lds, G, 0, 0, true))
    RUN(PH_L0_F2, run_dn(a, lds, G, 0, 1))
    RUN(PH_HG_IN, {
        pg8::Gemm g{(const bf16_t*)(ws + WS_HB) + (size_t)ROW_X * DM, (const bf16_t*)(ws + WS_WHI), SEQ, HG_N, DM}; pg8::StaticOrder S; S.init(SEQ, HG_N, G, (int)blockIdx.x);
        EpiHgIn E{(bf16_t*)(ws + WS_QB), (bf16_t*)(ws + WS_KB), (bf16_t*)(ws + WS_VB), (bf16_t*)(ws + WS_GB), (float*)(ws + WS_LF), (const float*)(ws + WS_LB), (const float*)(ws + WS_SSQ) + (size_t)1 * TR};
        zero_pad_rows(ws, true, G);
        { SkHgIn K{E.QB, E.KB, E.VB, E.GB, E.LF, E.LBv, E.ssq}; skinny_phase<1, SkHgIn>(lds, (const bf16_t*)(ws + WS_HB) + (size_t)ROW_META * DM, g.Bt, DM, HG_N / 64, K, G); }
        pg8::gemm_phase<EpiHgIn>(lds, g, S, E); })
    RUN(PH_H1, phase_h1(a, lds, G))
    RUN(PH_H2, phase_h2(a, G))
    RUN(PH_H3, phase_h3(a, lds, G))
    RUN(PH_HG_OUT, run_out(a, lds, G, WS_WHO, 2, true))
    RUN(PH_L0_F3, run_gu(a, lds, G, 1, 2, true))
    RUN(PH_L0_F4, run_dn(a, lds, G, 1, 3))
    RUN(PH_L1_F1, run_gu(a, lds, G, 2, 3, true))
    RUN(PH_L1_F2, run_dn(a, lds, G, 2, 4))
    RUN(PH_FX_IN, {
        pg8::Gemm g{(const bf16_t*)(ws + WS_HB) + (size_t)ROW_X * DM, (const bf16_t*)(ws + WS_WFI), SEQ, 8192, DM}; pg8::StaticOrder S; S.init(SEQ, 8192, G, (int)blockIdx.x);
        EpiFoxIn E{(bf16_t*)(ws + WS_QB), (bf16_t*)(ws + WS_KB), (bf16_t*)(ws + WS_VB), (bf16_t*)(ws + WS_GB), (float*)(ws + WS_LFX), a.fox_b_f, (const float*)(ws + WS_SSQ) + (size_t)4 * TR};
        zero_pad_rows(ws, false, G);
        { SkFoxIn K{E.QB, E.KB, E.VB, E.GB, E.LFX, E.bfv, E.ssq}; skinny_phase<1, SkFoxIn>(lds, (const bf16_t*)(ws + WS_HB) + (size_t)ROW_META * DM, g.Bt, DM, 8192 / 64 + 1, K, G); }
        { SkFgate K{E.LFX, E.bfv, E.ssq}; skinny_phase<1, SkFgate>(lds, (const bf16_t*)(ws + WS_WFI) + (size_t)8192 * DM, (const bf16_t*)(ws + WS_HB) + (size_t)ROW_X * DM, DM, SEQ / 64, K, G); }
        pg8::gemm_phase<EpiFoxIn>(lds, g, S, E); })
    RUN(PH_X2, phase_x2(a, G))
    RUN(PH_X3, phase_x3(a, ldsg, G))
    RUN(PH_FX_OUT, run_out(a, lds, G, WS_WFO, 5, false))
    RUN(PH_L1_F3, run_gu(a, lds, G, 3, 5, false))
    RUN(PH_L1_F4, {
        pg8::Gemm g{(const bf16_t*)(ws + WS_ACT) + (size_t)ROW_X * FF, (const bf16_t*)(ws + WS_WDN + 3 * SZ_WDN1), SEQ, DM, FF}; pg8::StaticOrder S; S.init(SEQ, DM, G, (int)blockIdx.x);
        EpiResid<true> E{(bf16_t*)(ws + WS_HB), nullptr, a.out, 0.5f};
        pg8::gemm_phase<EpiResid<true>>(lds, g, S, E); })
#undef RUN
}

#ifndef N_LAUNCH_SPLIT
#define N_LAUNCH_SPLIT 0
#endif
extern "C" void kernel_launch(void* const* d_in, const int* in_sizes, int n_in, void* d_out, int out_size, void* d_ws, size_t ws_size, hipStream_t stream) {
    static int grid = 0;
    if (grid == 0) {
        if (n_in != 14 || ws_size < WS_END) { fprintf(stderr, "kernel_launch: unexpected inputs (n_in %d, ws %zu < %zu)\n", n_in, ws_size, (size_t)WS_END); grid = -1; return; }
        int dev = 0, cus = 0, per_cu = 0;
        (void)hipGetDevice(&dev); (void)hipDeviceGetAttribute(&cus, hipDeviceAttributeMultiprocessorCount, dev);
        if (hipFuncSetAttribute((const void*)fwd_megakernel, hipFuncAttributeMaxDynamicSharedMemorySize, LDS_BYTES) != hipSuccess) { fprintf(stderr, "kernel_launch: hipFuncSetAttribute failed\n"); grid = -1; return; }
        if (hipOccupancyMaxActiveBlocksPerMultiprocessor(&per_cu, (const void*)fwd_megakernel, NTHREADS, LDS_BYTES) != hipSuccess || per_cu < 1) { fprintf(stderr, "kernel_launch: occupancy query says %d\n", per_cu); per_cu = 1; }
        (void)hipGetLastError();
        grid = cus > 0 ? cus : 256;
    }
    if (grid < 0) return;
    (void)hipMemsetAsync((char*)d_ws + WS_CTL, 0, 16384, stream);
    Args a{};
    a.x = (const float*)d_in[0]; a.meta = (const float*)d_in[1]; a.norm_g = (const float*)d_in[2]; a.w_gu = (const float*)d_in[3]; a.w_dn = (const float*)d_in[4];
    a.lb_logits = (const float*)d_in[5]; a.hg_w_in = (const float*)d_in[6]; a.hg_w_out = (const float*)d_in[7]; a.hg_onorm = (const float*)d_in[8]; a.fox_w_in = (const float*)d_in[9];
    a.fox_b_f = (const float*)d_in[10]; a.fox_w_out = (const float*)d_in[11]; a.fox_qnorm = (const float*)d_in[12]; a.fox_knorm = (const float*)d_in[13];
    a.out = (float*)d_out; a.ws = (unsigned char*)d_ws;
#if N_LAUNCH_SPLIT
    for (int ph = 0; ph < NPH; ++ph) { a.ph_lo = ph; a.ph_hi = ph + 1; void* args[] = {&a};
        hipError_t e = hipLaunchCooperativeKernel((const void*)fwd_megakernel, dim3(grid), dim3(NTHREADS), args, LDS_BYTES, stream);
        if (e != hipSuccess) { fprintf(stderr, "cooperative launch failed: %s\n", hipGetErrorString(e)); break; } }
#else
    a.ph_lo = 0; a.ph_hi = NPH; void* args[] = {&a};
    hipError_t e = hipLaunchCooperativeKernel((const void*)fwd_megakernel, dim3(grid), dim3(NTHREADS), args, LDS_BYTES, stream);
    if (e != hipSuccess) fprintf(stderr, "cooperative launch failed: %s (grid %d)\n", hipGetErrorString(e), grid);
#endif
}
```
